# Optimizing an MI355X kernel written in HIP

```python
import jax, jax.numpy as jnp
from jax import lax
import numpy as np

D_MODEL = 1024
BATCH = 8
SEQ = 4096
DEPTH = 2

MEM_LEN = 256
GRID_W = 64
EPS = 1e-6

GLA_HEADS = 4
GLA_DK = 128
GLA_DV = 256
GLA_QK = GLA_HEADS * GLA_DK
GLA_V = GLA_HEADS * GLA_DV
GLA_RANK = 16
GLA_TAU = 16.0
GLA_CHUNK = 64

NA_HEADS = 8
NA_HD = 64
NA_W = NA_HEADS * NA_HD
NA_ROWS = 8
NA_COLS = 16

MEM_HEADS = 4
MEM_HD = 128
MEM_W = MEM_HEADS * MEM_HD

N_BRANCH = 3

IN_SPLIT_SIZES = (GLA_QK, GLA_QK, GLA_V, GLA_V, GLA_RANK, GLA_RANK,
                  NA_W, NA_W, NA_W, NA_W,
                  MEM_W, MEM_W,
                  N_BRANCH * D_MODEL)
IN_COLS = sum(IN_SPLIT_SIZES)

kernel_name = "hybrid_gla_natten_memory_gated_encoder"


def rmsnorm(x, g):
    xf = x.astype(jnp.float32)
    y = xf * lax.rsqrt(jnp.mean(xf * xf, axis=-1, keepdims=True) + EPS)
    return (y * g.astype(jnp.float32)).astype(x.dtype)


def gla_scan(q, k, v, g):
    B, H, T, dk = q.shape
    dv = v.shape[-1]
    C = GLA_CHUNK
    NC = T // C

    def chunks(a):
        return jnp.moveaxis(a.reshape(B, H, NC, C, a.shape[-1]), 2, 0)

    qc, kc, vc = chunks(q), chunks(k), chunks(v)
    bc = jnp.cumsum(chunks(g), axis=3)
    mask = jnp.tril(jnp.ones((C, C), dtype=bool))[:, :, None]

    def step(S, inp):
        qi, ki, vi, bi = inp
        o_inter = jnp.einsum('bhik,bhkv->bhiv', qi * jnp.exp(bi), S)
        diff = bi[:, :, :, None, :] - bi[:, :, None, :, :]
        decay = jnp.exp(jnp.where(mask, diff, -jnp.inf))
        A = jnp.einsum('bhijk,bhjk->bhij', qi[:, :, :, None, :] * decay, ki)
        o = o_inter + jnp.einsum('bhij,bhjv->bhiv', A, vi)
        b_last = bi[:, :, -1:, :]
        S = jnp.exp(b_last[:, :, 0, :])[..., None] * S + jnp.einsum(
            'bhjk,bhjv->bhkv', ki * jnp.exp(b_last - bi), vi)
        return S, o

    S0 = jnp.zeros((B, H, dk, dv), jnp.float32)
    _, o = lax.scan(step, S0, (qc, kc, vc, bc))
    return jnp.moveaxis(o, 0, 2).reshape(B, H, T, dv)


def neighbourhood_attention(q, k, v, rpb):
    B, S, H, hd = q.shape
    rows = S // GRID_W
    kr = min(NA_ROWS, rows)
    qg = q.reshape(B, rows, GRID_W, H, hd)
    kg = k.reshape(B, rows, GRID_W, H, hd)
    vg = v.reshape(B, rows, GRID_W, H, hd)
    col = np.arange(GRID_W)
    cs = np.clip(col - NA_COLS // 2, 0, GRID_W - NA_COLS)
    col_idx = cs[:, None] + np.arange(NA_COLS)[None, :]
    dc_idx = (col_idx - col[:, None]) + (NA_COLS - 1)

    def row_block(r):
        rs = jnp.clip(r - kr // 2, 0, rows - kr)
        q_row = lax.dynamic_index_in_dim(qg, r, axis=1, keepdims=False)
        k_band = lax.dynamic_slice_in_dim(kg, rs, kr, axis=1)
        v_band = lax.dynamic_slice_in_dim(vg, rs, kr, axis=1)
        k_nb = k_band[:, :, col_idx]
        v_nb = v_band[:, :, col_idx]
        dr_idx = rs + jnp.arange(kr) - r + (NA_ROWS - 1)
        bias = rpb[:, dr_idx[None, :, None], dc_idx[:, None, :]]
        s = jnp.einsum('bqhd,bkqjhd->bhqkj', q_row, k_nb).astype(jnp.float32) \
            + bias.astype(jnp.float32)
        p = jax.nn.softmax(s.reshape(B, H, GRID_W, kr * NA_COLS), axis=-1)
        p = p.reshape(s.shape).astype(v.dtype)
        return jnp.einsum('bhqkj,bkqjhd->bqhd', p, v_nb)

    out = lax.map(row_block, jnp.arange(rows))
    return jnp.moveaxis(out, 0, 1).reshape(B, S, H * hd)


def memory_attention(q, k, v):
    s = jnp.einsum('bshd,bmhd->bhsm', q, k).astype(jnp.float32)
    p = jax.nn.softmax(s, axis=-1).astype(v.dtype)
    return jnp.einsum('bhsm,bmhd->bshd', p, v)


def setup_inputs(seed: int = 0) -> dict:
    key = jax.random.key(seed)
    ks = jax.random.split(key, 24)
    L, D = DEPTH, D_MODEL
    n = lambda k, s, sc: jax.random.normal(k, s, jnp.float32) * sc
    gain = lambda k, s: 1.0 + 0.05 * jax.random.normal(k, s, jnp.float32)
    return {
        "x": jax.random.normal(ks[0], (BATCH, SEQ, D), jnp.float32),
        "mem": jax.random.normal(ks[1], (BATCH, MEM_LEN, D), jnp.float32),
        "norm_g": gain(ks[2], (L, D)),
        "w_in": n(ks[3], (L, D, IN_COLS), D ** -0.5),
        "gla_w2_f": n(ks[4], (L, GLA_RANK, GLA_QK), GLA_RANK ** -0.5),
        "gla_b_f": n(ks[5], (L, GLA_QK), 0.1),
        "gla_w2_b": n(ks[6], (L, GLA_RANK, GLA_QK), GLA_RANK ** -0.5),
        "gla_b_b": n(ks[7], (L, GLA_QK), 0.1),
        "gla_out_g": gain(ks[8], (L, GLA_DV)),
        "p_a": n(ks[9], (L, GLA_V, D), GLA_V ** -0.5),
        "na_q_g": gain(ks[10], (L, NA_HD)),
        "na_k_g": gain(ks[11], (L, NA_HD)),
        "na_rpb": n(ks[12], (L, NA_HEADS, 2 * NA_ROWS - 1, 2 * NA_COLS - 1), 0.1),
        "p_b": n(ks[13], (L, NA_W, D), NA_W ** -0.5),
        "mem_norm_g": gain(ks[14], (L, D)),
        "w_mem_kv": n(ks[15], (L, D, 2 * MEM_W), D ** -0.5),
        "mem_q_g": gain(ks[16], (L, MEM_HD)),
        "mem_k_g": gain(ks[17], (L, MEM_HD)),
        "p_c": n(ks[18], (L, MEM_W, D), MEM_W ** -0.5),
        "w_out": n(ks[19], (L, D, D), D ** -0.5),
    }


def reference(x, mem, norm_g, w_in, gla_w2_f, gla_b_f, gla_w2_b, gla_b_b, gla_out_g, p_a,
              na_q_g, na_k_g, na_rpb, p_b, mem_norm_g, w_mem_kv, mem_q_g, mem_k_g, p_c,
              w_out):
    B, S, D = x.shape
    M = mem.shape[1]
    f32 = jnp.float32
    split_idx = np.cumsum(IN_SPLIT_SIZES)[:-1]

    def heads_first(a, h, d):
        return a.reshape(B, S, h, d).transpose(0, 2, 1, 3).astype(f32)

    for l in range(DEPTH):
        h = rmsnorm(x, norm_g[l])
        proj = h @ w_in[l]
        (gq, gk, gv, ggate, glr_f, glr_b, nq, nk, nv, ngate, mq, mgate, merge) = \
            jnp.split(proj, split_idx, axis=-1)

        qa = heads_first(gq, GLA_HEADS, GLA_DK) * (GLA_DK ** -0.5)
        ka = heads_first(gk, GLA_HEADS, GLA_DK)
        va = heads_first(gv, GLA_HEADS, GLA_DV)
        g_f = jax.nn.log_sigmoid((glr_f @ gla_w2_f[l] + gla_b_f[l]).astype(f32)) / GLA_TAU
        g_b = jax.nn.log_sigmoid((glr_b @ gla_w2_b[l] + gla_b_b[l]).astype(f32)) / GLA_TAU
        g_f = heads_first(g_f, GLA_HEADS, GLA_DK)
        g_b = heads_first(g_b, GLA_HEADS, GLA_DK)
        o_fwd = gla_scan(qa, ka, va, g_f)
        o_bwd = jnp.flip(gla_scan(jnp.flip(qa, 2), jnp.flip(ka, 2), jnp.flip(va, 2),
                                  jnp.flip(g_b, 2)), 2)
        oa = (o_fwd + o_bwd).transpose(0, 2, 1, 3)
        oa = rmsnorm(oa, gla_out_g[l]).reshape(B, S, GLA_V).astype(x.dtype)
        ya = (oa * jax.nn.silu(ggate)) @ p_a[l]

        qb = rmsnorm(nq.reshape(B, S, NA_HEADS, NA_HD), na_q_g[l]) * (NA_HD ** -0.5)
        kb = rmsnorm(nk.reshape(B, S, NA_HEADS, NA_HD), na_k_g[l])
        vb = nv.reshape(B, S, NA_HEADS, NA_HD)
        ob = neighbourhood_attention(qb, kb, vb, na_rpb[l])
        yb = (ob * jax.nn.silu(ngate)) @ p_b[l]

        mem_kv = rmsnorm(mem, mem_norm_g[l]) @ w_mem_kv[l]
        mk, mv = jnp.split(mem_kv, 2, axis=-1)
        kc = rmsnorm(mk.reshape(B, M, MEM_HEADS, MEM_HD), mem_k_g[l])
        vc = mv.reshape(B, M, MEM_HEADS, MEM_HD)
        qc = rmsnorm(mq.reshape(B, S, MEM_HEADS, MEM_HD), mem_q_g[l]) * (MEM_HD ** -0.5)
        oc = memory_attention(qc, kc, vc).reshape(B, S, MEM_W)
        yc = (oc * jax.nn.silu(mgate)) @ p_c[l]

        gate_a, gate_b, gate_c = jnp.split(jax.nn.sigmoid(merge), N_BRANCH, axis=-1)
        y = gate_a * ya + gate_b * yb + gate_c * yc
        x = x + y @ w_out[l]
    return x
```

```cpp
#include <hip/hip_runtime.h>
#include <cstdio>
#include <cstdint>

#ifndef MK_N_LAUNCHES
#define MK_N_LAUNCHES 1
#endif

#ifndef PROBE_REP
#define PROBE_REP -1
#endif
#define LAS __attribute__((address_space(3)))
#define GAS __attribute__((address_space(1)))
typedef unsigned short bf16_t;
typedef short bf16x8 __attribute__((ext_vector_type(8)));
typedef short s16x4 __attribute__((ext_vector_type(4)));
typedef float f32x4 __attribute__((ext_vector_type(4)));
typedef float f32x16 __attribute__((ext_vector_type(16)));
typedef float f32x2 __attribute__((ext_vector_type(2)));
typedef unsigned u32x4 __attribute__((ext_vector_type(4)));
typedef unsigned u32x2 __attribute__((ext_vector_type(2)));
typedef __bf16 bf16x2_t __attribute__((ext_vector_type(2)));

constexpr int DM = 1024, NB = 8, SEQ = 4096, T = NB * SEQ, DEPTH = 2, MEML = 256, TMEM = NB * MEML;
constexpr int IN_COLS = 9248;
constexpr float EPS = 1e-6f, LOG2E = 1.4426950408889634f;
constexpr int NWAVES = 8, NTHR = 512;
constexpr int N1 = 4352;
constexpr int KP3 = 5120;

constexpr size_t MiB = 1u << 20;
constexpr size_t WS_CTL = 0;
constexpr size_t WS_WIN = 1 * MiB;
constexpr size_t WS_WGATE = WS_WIN + (size_t)N1 * 1024 * 2;
constexpr size_t WS_WP3 = WS_WGATE + (size_t)2048 * 1024 * 2;
constexpr size_t WS_WOUT = WS_WP3 + (size_t)1024 * KP3 * 2;
constexpr size_t WS_WMEM = WS_WOUT + (size_t)1024 * 1024 * 2;
constexpr size_t WS_HMEM = WS_WMEM + (size_t)1024 * 1024 * 2;
constexpr size_t WS_MK = WS_HMEM + (size_t)TMEM * 1024 * 2;
constexpr size_t WS_MV = WS_MK + (size_t)TMEM * 512 * 2;
constexpr size_t WS_GLR = WS_MV + (size_t)TMEM * 512 * 2;
constexpr size_t WS_H = 40 * MiB;
constexpr size_t WS_GQ = WS_H + 64 * MiB;
constexpr size_t WS_GK = WS_GQ + 32 * MiB;
constexpr size_t WS_GV = WS_GK + 32 * MiB;
constexpr size_t WS_NMQ = WS_GV + 64 * MiB;
constexpr size_t WS_NK = WS_NMQ + 64 * MiB;
constexpr size_t WS_NV = WS_NK + 32 * MiB;
constexpr size_t WS_OF = WS_NV + 32 * MiB;
constexpr size_t WS_OB = WS_OF + 64 * MiB;
constexpr size_t WS_DEC = WS_OB + 64 * MiB;
constexpr size_t WS_END = WS_DEC + 2 * MiB;
constexpr size_t WS_QEB = WS_OB, WS_KEB = WS_OB + 32 * MiB;
constexpr size_t WS_OBW = WS_NK;
constexpr size_t WS_Y = WS_GQ;
constexpr size_t WS_SG = WS_GV;
static_assert(WS_GLR + (size_t)T * 32 * 4 <= WS_H, "ws map");
static_assert(WS_END <= 512 * MiB, "ws map");

constexpr int LDS_EPI = 131072;
constexpr int LDS_CTLW = 159744;
constexpr int LDS_BYTES = 160768;

__device__ __forceinline__ unsigned cvtpk(float lo, float hi) { f32x2 v = {lo, hi}; bf16x2_t b = __builtin_convertvector(v, bf16x2_t); return __builtin_bit_cast(unsigned, b); }
__device__ __forceinline__ float bf_lo(unsigned u) { return __builtin_bit_cast(float, u << 16); }
__device__ __forceinline__ float bf_hi(unsigned u) { return __builtin_bit_cast(float, u & 0xffff0000u); }
__device__ __forceinline__ float fexp2(float x) { return __builtin_amdgcn_exp2f(x); }
__device__ __forceinline__ float frcp(float x) { return __builtin_amdgcn_rcpf(x); }
__device__ __forceinline__ float silu_f(float a) { return a * frcp(1.f + fexp2(-a * LOG2E)); }
__device__ __forceinline__ float sigmoid_f(float a) { return frcp(1.f + fexp2(-a * LOG2E)); }
__device__ __forceinline__ unsigned opaque(unsigned v) { asm volatile("" : "+v"(v)); return v; }
__device__ __forceinline__ float frsq(float x) { return __builtin_amdgcn_rsqf(x); }
__device__ __forceinline__ int tid_of(int wv) { unsigned l_; asm volatile("v_mbcnt_lo_u32_b32 %0, -1, 0\n\tv_mbcnt_hi_u32_b32 %0, -1, %0" : "=v"(l_)); return wv * 64 + (int)l_; }
__device__ __forceinline__ float bperm(float v, int src_lane) { return __builtin_bit_cast(float, __builtin_amdgcn_ds_bpermute(src_lane << 2, __builtin_bit_cast(int, v))); }
__device__ __forceinline__ float wave_sum(float v, int lane) {
#pragma unroll
    for (int o = 1; o < 64; o <<= 1) v += bperm(v, lane ^ o);
    return v;
}
__device__ __forceinline__ s16x4 tr_read(const LAS unsigned char* p) { return __builtin_bit_cast(s16x4, __builtin_amdgcn_ds_read_tr16_b64_v4i16((LAS s16x4*)p)); }
__device__ __forceinline__ bf16x8 cat44(s16x4 a, s16x4 b) { return (bf16x8){a[0], a[1], a[2], a[3], b[0], b[1], b[2], b[3]}; }
__device__ __forceinline__ f32x4 mfma16(bf16x8 a, bf16x8 b, f32x4 c) { return __builtin_amdgcn_mfma_f32_16x16x32_bf16(a, b, c, 0, 0, 0); }
__device__ __forceinline__ f32x16 mfma32(bf16x8 a, bf16x8 b, f32x16 c) { return __builtin_amdgcn_mfma_f32_32x32x16_bf16(a, b, c, 0, 0, 0); }

namespace pg8 {
constexpr int BM = 256, BK = 64, HALF = 128, HTB = HALF * BK * 2, STAGE_BYTES = 8 * HTB, NXCD = 8, WGM = 8;
__host__ __device__ __forceinline__ int lds_byte(int r, int c) { const int st = (r >> 4) * 2 + (c >> 5), rr = r & 15, cc = c & 31, ob = rr * 64 + cc * 2; return st * 1024 + (ob ^ (((ob >> 9) & 1) << 5)); }
__host__ __device__ __forceinline__ void stage_rc(int b, int& R, int& C) { const int st = b / 1024, sb = b % 1024, swz = sb ^ (((sb >> 9) & 1) << 5); R = (st >> 1) * 16 + swz / 64; C = (st & 1) * 32 + (swz % 64) / 2; }
__host__ __device__ __forceinline__ int perm32(int rho) { const int n = rho >> 4, i = rho & 15; return 8 * (i >> 2) + 4 * n + (i & 3); }

struct Unit { const char* A; const char* B; int nt; int pm, pn, kind; };
__device__ __forceinline__ void tile_of(int L, int nM, int nN, int& pm, int& pn) {
    const int nwg = nM * nN; int wgid = L; { const int q = nwg / NXCD, r = nwg % NXCD, xcd = wgid % NXCD, off = wgid / NXCD; wgid = (xcd < r ? xcd * (q + 1) : r * (q + 1) + (xcd - r) * q) + off; }
    const int nig = WGM * nN, gid = wgid / nig, fm = gid * WGM, gsz = (nM - fm) < WGM ? (nM - fm) : WGM;
    pm = fm + ((wgid % nig) % gsz); pn = (wgid % nig) / gsz;
}

template <class Epi, class Sched>
__device__ __forceinline__ void gemm_phase(LAS unsigned char* lds, const int lda, const int ldb, const Sched& S, const Epi& E, const int wv) {
    const int tid = tid_of(wv), wid = __builtin_amdgcn_readfirstlane(tid >> 6), lane = tid & 63, wr = wid >> 2, wc = wid & 3, fr = lane & 15, fq = lane >> 4;
    unsigned voffA[2], voffB[2];
#pragma unroll
    for (int i = 0; i < 2; ++i) { int R, C; stage_rc(tid * 16 + i * 8192, R, C); const int Rb = (R & ~31) + perm32(R & 31);
        voffA[i] = (unsigned)(R * lda + C) * 2u; voffB[i] = (unsigned)(Rb * ldb + C) * 2u; }
    const size_t kstep = (size_t)(BK * 2);
    const size_t hstepA = (size_t)HALF * lda * 2, hstepB = (size_t)HALF * ldb * 2;
    const unsigned ldsw = (unsigned)wid * 1024u;
    const int aoff = lds_byte(wr * 64 + fr, fq * 8), boff = lds_byte(wc * 32 + fr, fq * 8);
#define PG8_SA(b, h) (((b) * 2 + (h)) * HTB)
#define PG8_SB(b, h) ((4 + (b) * 2 + (h)) * HTB)
#define PG8_STAGE(bufoff, gbase, voff) do { _Pragma("unroll") for (int _i = 0; _i < 2; ++_i) \
        __builtin_amdgcn_global_load_lds((const unsigned*)((const char*)(gbase) + (voff)[_i]), (LAS unsigned*)(lds + (bufoff) + ldsw + _i * 8192), 16, 0, 0); } while (0)
#define PG8_LDA(dst, b, h) do { _Pragma("unroll") for (int m = 0; m < 4; ++m) _Pragma("unroll") for (int k = 0; k < 2; ++k) dst[m][k] = *(const LAS bf16x8*)(lds + PG8_SA(b, h) + aoff + m * 2048 + k * 1024); } while (0)
#define PG8_LDB(dst, b, h) do { _Pragma("unroll") for (int n = 0; n < 2; ++n) _Pragma("unroll") for (int k = 0; k < 2; ++k) dst[n][k] = *(const LAS bf16x8*)(lds + PG8_SB(b, h) + boff + n * 2048 + k * 1024); } while (0)
#define PG8_MMA(ai, bj, At, Bt) do { __builtin_amdgcn_s_setprio(1); _Pragma("unroll") for (int m = 0; m < 4; ++m) _Pragma("unroll") for (int n = 0; n < 2; ++n) _Pragma("unroll") for (int k = 0; k < 2; ++k) \
        acc[ai][bj][m][n] = __builtin_amdgcn_mfma_f32_16x16x32_bf16(Bt[n][k], At[m][k], acc[ai][bj][m][n], 0, 0, 0); __builtin_amdgcn_s_setprio(0); } while (0)
#define PG8_WAIT_V(n) asm volatile("s_waitcnt vmcnt(" #n ")" ::: "memory")
#define PG8_WAIT_L(n) asm volatile("s_waitcnt lgkmcnt(" #n ")" ::: "memory")
#define PG8_BAR __builtin_amdgcn_s_barrier()
#define PG8_SCHED __builtin_amdgcn_sched_barrier(0)
    Unit cur, nxt; int ui = 0;
    typename Epi::State est;
    if (!S.next(0, cur)) return;
    const char* cA = cur.A; const char* cB = cur.B;
    PG8_STAGE(PG8_SB(0, 0), cB, voffB); PG8_STAGE(PG8_SB(0, 1), cB + hstepB, voffB); PG8_STAGE(PG8_SA(0, 0), cA, voffA); PG8_STAGE(PG8_SA(0, 1), cA + hstepA, voffA);
    if (wr == 1) PG8_BAR;
    PG8_WAIT_V(2); PG8_BAR;
    PG8_STAGE(PG8_SB(1, 0), cB + kstep, voffB); PG8_STAGE(PG8_SA(1, 0), cA + kstep, voffA); PG8_STAGE(PG8_SB(1, 1), cB + hstepB + kstep, voffB);
    PG8_WAIT_V(0); PG8_BAR;
    asm volatile("" ::: "memory");
    f32x4 acc[2][2][4][2];
#pragma unroll
    for (int a = 0; a < 2; ++a)
#pragma unroll
        for (int b = 0; b < 2; ++b)
#pragma unroll
            for (int m = 0; m < 4; ++m)
#pragma unroll
                for (int n = 0; n < 2; ++n) acc[a][b][m][n] = (f32x4){0.f, 0.f, 0.f, 0.f};
    bf16x8 At[4][2], B0[2][2], B1[2][2];
    for (;;) {
        const bool has_next = S.next(ui + 1, nxt);
        const char* nA = has_next ? nxt.A : cA; const char* nB = has_next ? nxt.B : cB;
        const int nt = cur.nt;
        for (int t = 0; t < nt; t += 2) {
            const bool last = (t == nt - 2);
            const char* a1 = cA + (size_t)(t + 1) * kstep;
            const char* a2 = last ? nA : cA + (size_t)(t + 2) * kstep; const char* b2 = last ? nB : cB + (size_t)(t + 2) * kstep;
            const char* a3 = a2 + kstep; const char* b3 = b2 + kstep;
            int tz = t; asm volatile("" : "+s"(tz));
            PG8_LDB(B0, 0, 0); PG8_LDB(B1, 0, 1); PG8_SCHED; PG8_LDA(At, 0, 0); PG8_STAGE(PG8_SA(1, 1), a1 + hstepA, voffA);
            if (tz != 0) PG8_WAIT_V(8);
            PG8_WAIT_L(0); PG8_BAR; PG8_MMA(0, 0, At, B0); PG8_MMA(0, 1, At, B1); PG8_BAR; PG8_SCHED;
            PG8_LDA(At, 0, 1); PG8_STAGE(PG8_SB(0, 0), b2, voffB); PG8_STAGE(PG8_SB(0, 1), b2 + hstepB, voffB); PG8_STAGE(PG8_SA(0, 0), a2, voffA);
            if (tz != 0) PG8_WAIT_V(8);
            PG8_WAIT_L(0); PG8_BAR; PG8_MMA(1, 0, At, B0); PG8_MMA(1, 1, At, B1); PG8_BAR; PG8_SCHED;
            PG8_LDB(B0, 1, 0); PG8_LDB(B1, 1, 1); PG8_SCHED; PG8_LDA(At, 1, 0); PG8_STAGE(PG8_SA(0, 1), a2 + hstepA, voffA);
            PG8_WAIT_V(8); PG8_WAIT_L(0); PG8_BAR; PG8_MMA(0, 0, At, B0); PG8_MMA(0, 1, At, B1); PG8_BAR; PG8_SCHED;
            PG8_LDA(At, 1, 1); PG8_STAGE(PG8_SB(1, 0), b3, voffB); PG8_STAGE(PG8_SB(1, 1), b3 + hstepB, voffB); PG8_STAGE(PG8_SA(1, 0), a3, voffA);
            PG8_WAIT_V(8); PG8_WAIT_L(0); PG8_BAR; PG8_MMA(1, 0, At, B0); PG8_MMA(1, 1, At, B1); PG8_BAR; PG8_SCHED;
        }
        PG8_WAIT_V(0);
        if (wr == 0) PG8_BAR;
        E(acc, cur, wr, wc, fr, fq, lds + LDS_EPI, est);
        if (!has_next) break;
#pragma unroll
        for (int a = 0; a < 2; ++a)
#pragma unroll
            for (int b = 0; b < 2; ++b)
#pragma unroll
                for (int m = 0; m < 4; ++m)
#pragma unroll
                    for (int n = 0; n < 2; ++n) acc[a][b][m][n] = (f32x4){0.f, 0.f, 0.f, 0.f};
        cur = nxt; cA = nA; cB = nB; ++ui;
        if (wr == 1) PG8_BAR;
    }
    PG8_WAIT_V(0);
    PG8_BAR;
#undef PG8_SA
#undef PG8_SB
#undef PG8_STAGE
#undef PG8_LDA
#undef PG8_LDB
#undef PG8_MMA
}
#define GOFF(g) ((size_t)(((g) >> 2) * 128 + ((g) & 3) * 16) * 2048)
#define EPI_BAR() do { asm volatile("s_waitcnt lgkmcnt(0)" ::: "memory"); __builtin_amdgcn_s_barrier(); asm volatile("" ::: "memory"); } while (0)

__device__ __forceinline__ void ssq_put(float s, int rowt, int bj, int wc, int fq, LAS float* P) {
    const int ln_ = (rowt & 15) | (fq << 4);
    s += bperm(s, ln_ ^ 16); s += bperm(s, ln_ ^ 32);
    if (fq == 0) P[rowt * 8 + bj * 4 + wc] = s;
}
}
using pg8::Unit;

struct Args { const float* in[20]; float* out; unsigned char* ws; int ph_lo, ph_hi; };

struct Ptrs {
    const float *x, *mem, *norm_g, *w_in, *w2f, *bf, *w2b, *bb, *gla_out_g, *p_a, *na_q_g, *na_k_g, *rpb, *p_b, *mem_norm_g, *w_mem, *mem_q_g, *mem_k_g, *p_c, *w_out;
    float* out; unsigned char* ws;
};

__device__ __forceinline__ void p0_transpose_item(const float* W, int srcN, int c0, int ncols, bf16_t* WT, int row0, int ld, int koff, LAS float* scr, int item, int lane) {
    const int nblk = ncols / 32, kb = item / nblk, nb = item % nblk, k0 = 64 * kb, n0 = 32 * nb;
#pragma unroll 8
    for (int i = 0; i < 32; ++i) { const int kk = 2 * i + (lane >> 5); scr[kk * 33 + (lane & 31)] = W[(size_t)(k0 + kk) * srcN + c0 + n0 + (lane & 31)]; }
    asm volatile("s_waitcnt lgkmcnt(0)" ::: "memory");
    const int c = lane & 7;
#pragma unroll
    for (int j = 0; j < 4; ++j) { const int n = (lane >> 3) + 8 * j; const LAS float* s = scr + (8 * c) * 33 + n;
        u32x4 o; o.x = cvtpk(s[0 * 33], s[1 * 33]); o.y = cvtpk(s[2 * 33], s[3 * 33]); o.z = cvtpk(s[4 * 33], s[5 * 33]); o.w = cvtpk(s[6 * 33], s[7 * 33]);
        *(u32x4*)(WT + (size_t)(row0 + n0 + n) * ld + koff + k0 + 8 * c) = o; }
    asm volatile("s_waitcnt lgkmcnt(0)" ::: "memory");
}
__device__ __forceinline__ void rms_rows_to_bf16(const float* X, const float* g, bf16_t* O, int m0, int step, int nrows, int lane) {
    if (m0 >= nrows) return;
    const f32x4* gr = (const f32x4*)g + lane;
    f32x4 gg[4];
#pragma unroll
    for (int j = 0; j < 4; ++j) gg[j] = gr[64 * j];
    f32x4 vn[4];
    { const f32x4* xr = (const f32x4*)(X + (size_t)m0 * DM) + lane;
#pragma unroll
      for (int j = 0; j < 4; ++j) vn[j] = xr[64 * j]; }
    for (int m = m0; m < nrows; m += step) {
        f32x4 v[4];
#pragma unroll
        for (int j = 0; j < 4; ++j) v[j] = vn[j];
        if (m + step < nrows) { const f32x4* xr = (const f32x4*)(X + (size_t)(m + step) * DM) + lane;
#pragma unroll
            for (int j = 0; j < 4; ++j) vn[j] = xr[64 * j]; }
        float sq = 0.f;
#pragma unroll
        for (int j = 0; j < 4; ++j) sq += (v[j].x * v[j].x + v[j].y * v[j].y) + (v[j].z * v[j].z + v[j].w * v[j].w);
        const float rstd = 1.0f / sqrtf(wave_sum(sq, lane) * (1.f / DM) + EPS);
        u32x2* o8 = (u32x2*)(O + (size_t)m * DM) + lane;
#pragma unroll
        for (int j = 0; j < 4; ++j) { u32x2 w; w.x = cvtpk(v[j].x * rstd * gg[j].x, v[j].y * rstd * gg[j].y); w.y = cvtpk(v[j].z * rstd * gg[j].z, v[j].w * rstd * gg[j].w); o8[64 * j] = w; }
    }
}
struct Seg { int src, srcN, c0, ncols, K, dst, row0, ld, koff; };
__device__ __forceinline__ void p0_phase(const Ptrs& P, int l, LAS unsigned char* lds, int vcu, int G, const float* xin, const int wv) {
    const int tid = tid_of(wv), lane = tid & 63, wave = tid >> 6;
    LAS float* scr = (LAS float*)(lds + wave * 16384);
    const int gw = vcu * NWAVES + wave, NGW = G * NWAVES;
    constexpr int NSEG = 19;
    const Seg segs[NSEG] = {
        {0, IN_COLS, 0, 512, 1024, 0, 0, 1024, 0},
        {0, IN_COLS, 512, 512, 1024, 0, 512, 1024, 0},
        {0, IN_COLS, 1024, 1024, 1024, 0, 1024, 1024, 0},
        {0, IN_COLS, 3104, 512, 1024, 0, 2048, 1024, 0},
        {0, IN_COLS, 3616, 512, 1024, 0, 2560, 1024, 0},
        {0, IN_COLS, 4128, 512, 1024, 0, 3072, 1024, 0},
        {0, IN_COLS, 5152, 512, 1024, 0, 3584, 1024, 0},
        {0, IN_COLS, 3072, 32, 1024, 0, 4096, 1024, 0},
        {0, IN_COLS, 2048, 1024, 1024, 1, 0, 1024, 0},
        {0, IN_COLS, 4640, 512, 1024, 1, 1024, 1024, 0},
        {0, IN_COLS, 5664, 512, 1024, 1, 1536, 1024, 0},
        {0, IN_COLS, 6176, 1024, 1024, 2, 0, KP3, 0},
        {0, IN_COLS, 7200, 1024, 1024, 2, 0, KP3, 2048},
        {0, IN_COLS, 8224, 1024, 1024, 2, 0, KP3, 3584},
        {1, 1024, 0, 1024, 1024, 2, 0, KP3, 1024},
        {2, 1024, 0, 1024, 512, 2, 0, KP3, 3072},
        {3, 1024, 0, 1024, 512, 2, 0, KP3, 4608},
        {4, 1024, 0, 1024, 1024, 3, 0, 1024, 0},
        {5, 1024, 0, 1024, 1024, 4, 0, 1024, 0},
    };
    int total = 0;
#pragma unroll
    for (int s = 0; s < NSEG; ++s) total += (segs[s].K / 64) * (segs[s].ncols / 32);
    for (int it = gw; it < total; it += NGW) {
        int r = it;
#pragma unroll
        for (int s = 0; s < NSEG; ++s) {
            const int n = (segs[s].K / 64) * (segs[s].ncols / 32);
            if (r >= 0 && r < n) {
                const float* src = segs[s].src == 0 ? P.w_in + (size_t)l * 1024 * IN_COLS : segs[s].src == 1 ? P.p_a + (size_t)l * 1024 * 1024 : segs[s].src == 2 ? P.p_b + (size_t)l * 512 * 1024 :
                                   segs[s].src == 3 ? P.p_c + (size_t)l * 512 * 1024 : segs[s].src == 4 ? P.w_out + (size_t)l * 1024 * 1024 : P.w_mem + (size_t)l * 1024 * 1024;
                bf16_t* dst = (bf16_t*)(P.ws + (segs[s].dst == 0 ? WS_WIN : segs[s].dst == 1 ? WS_WGATE : segs[s].dst == 2 ? WS_WP3 : segs[s].dst == 3 ? WS_WOUT : WS_WMEM));
                p0_transpose_item(src, segs[s].srcN, segs[s].c0, segs[s].ncols, dst, segs[s].row0, segs[s].ld, segs[s].koff, scr, r, lane);
            }
            r -= n;
        }
    }
    { u32x4* z = (u32x4*)(P.ws + WS_WIN + (size_t)4128 * 1024 * 2); const int nz = 224 * 1024 * 2 / 16;
      const unsigned zz = opaque(0u);
      for (int i = vcu * NTHR + tid; i < nz; i += G * NTHR) z[i] = (u32x4){zz, zz, zz, zz}; }
    bf16_t* H = (bf16_t*)(P.ws + WS_H);
    rms_rows_to_bf16(xin, P.norm_g + l * DM, H, gw, NGW, T, lane);
    bf16_t* HM = (bf16_t*)(P.ws + WS_HMEM);
    rms_rows_to_bf16(P.mem, P.mem_norm_g + l * DM, HM, gw, NGW, TMEM, lane);
}

struct SchedP1 {
    const char* H; const char* W; const char* HM; const char* WM; int G, c;
    __device__ __forceinline__ bool next(int i, Unit& u) const {
        const int L = i * G + c; constexpr int NMAIN = 128 * 17;
        const bool mainu = L < NMAIN; const int r = L - NMAIN;
        if (!mainu && r >= 32) return false;
        int pm, pn; pg8::tile_of(mainu ? L : 0, 128, 17, pm, pn);
        if (!mainu) { pm = r >> 2; pn = r & 3; }
        const char* a = mainu ? H : HM; const char* b = mainu ? W : WM;
        Unit t; t.A = a + (size_t)pm * 256 * 1024 * 2; t.B = b + (size_t)pn * 256 * 1024 * 2; t.nt = 16; t.pm = pm; t.pn = pn; t.kind = mainu ? 0 : 1; u = t; return true;
    }
};
struct EpiNoState {};
struct EpiP1 {
    typedef EpiNoState State;
    unsigned char* ws; const float *na_q_g, *na_k_g, *mem_q_g, *mem_k_g; int skip;
    __device__ __forceinline__ void operator()(f32x4 (&acc)[2][2][4][2], const Unit& u, int wr, int wc, int fr_, int fq_, LAS unsigned char* le, State& est) const {
        if (skip == 1) { _Pragma("unroll") for (int a_ = 0; a_ < 2; ++a_) _Pragma("unroll") for (int m_ = 0; m_ < 4; ++m_) asm volatile("" :: "v"(acc[a_][0][m_][0]), "v"(acc[a_][0][m_][1]), "v"(acc[a_][1][m_][0]), "v"(acc[a_][1][m_][1])); return; }
        const int fr = (int)opaque((unsigned)fr_), fq = (int)opaque((unsigned)fq_);
        bf16_t* dst; int ldc, col0, mode = 0; float scale = 1.f; const float* gain = nullptr;
        const int pn = u.pn;
        bf16_t* const GQ = (bf16_t*)(ws + WS_GQ); bf16_t* const GK = (bf16_t*)(ws + WS_GK); bf16_t* const GV = (bf16_t*)(ws + WS_GV); bf16_t* const NMQ = (bf16_t*)(ws + WS_NMQ);
        bf16_t* const NK = (bf16_t*)(ws + WS_NK); bf16_t* const NV = (bf16_t*)(ws + WS_NV); bf16_t* const MK = (bf16_t*)(ws + WS_MK); bf16_t* const MV = (bf16_t*)(ws + WS_MV); float* const GLR = (float*)(ws + WS_GLR);
        if (u.kind == 0) {
            if (pn < 2) { dst = GQ; ldc = 512; col0 = pn * 256; scale = 0.08838834764831845f; }
            else if (pn < 4) { dst = GK; ldc = 512; col0 = (pn - 2) * 256; }
            else if (pn < 8) { dst = GV; ldc = 1024; col0 = (pn - 4) * 256; }
            else if (pn < 10) { dst = NMQ; ldc = 1024; col0 = (pn - 8) * 256; mode = 1; gain = na_q_g; scale = 0.125f * LOG2E; }
            else if (pn < 12) { dst = NK; ldc = 512; col0 = (pn - 10) * 256; mode = 1; gain = na_k_g; }
            else if (pn < 14) { dst = NV; ldc = 512; col0 = (pn - 12) * 256; }
            else if (pn < 16) { dst = NMQ; ldc = 1024; col0 = 512 + (pn - 14) * 256; mode = 2; gain = mem_q_g; scale = 0.08838834764831845f * LOG2E; }
            else { dst = nullptr; ldc = 0; col0 = 0; mode = 3; }
        } else {
            if (pn < 2) { dst = MK; ldc = 512; col0 = pn * 256; mode = 2; gain = mem_k_g; }
            else { dst = MV; ldc = 512; col0 = (pn - 2) * 256; }
        }
        if (mode == 3) {
            if (wc == 0) { const unsigned vo = opaque((unsigned)((wr * 64 + fr) * 64 + (fq >> 1) * 32 + (fq & 1) * 8) * 2u); char* ub = (char*)GLR + (size_t)u.pm * 256 * 64 * 2;
#pragma unroll
                for (int ai = 0; ai < 2; ++ai)
#pragma unroll
                    for (int m = 0; m < 4; ++m) { char* rp = ub + (ai * 128 + m * 16) * 64 * 2 + vo; const f32x4 a = acc[ai][0][m][0], b = acc[ai][0][m][1];
                        u32x4 hi; hi.x = cvtpk(a[0], a[1]); hi.y = cvtpk(a[2], a[3]); hi.z = cvtpk(b[0], b[1]); hi.w = cvtpk(b[2], b[3]);
                        u32x4 lo; lo.x = cvtpk(a[0] - bf_lo(hi.x), a[1] - bf_hi(hi.x)); lo.y = cvtpk(a[2] - bf_lo(hi.y), a[3] - bf_hi(hi.y)); lo.z = cvtpk(b[0] - bf_lo(hi.z), b[1] - bf_hi(hi.z)); lo.w = cvtpk(b[2] - bf_lo(hi.w), b[3] - bf_hi(hi.w));
                        *(u32x4*)rp = hi; *(u32x4*)(rp + 32) = lo; }
            }
            return;
        }
        f32x4 gv[2] = {(f32x4){1.f, 1.f, 1.f, 1.f}, (f32x4){1.f, 1.f, 1.f, 1.f}};
        LAS float* Pl = (LAS float*)le;
        if (mode != 0) {
#pragma unroll
            for (int ai = 0; ai < 2; ++ai)
#pragma unroll
                for (int m = 0; m < 4; ++m)
#pragma unroll
                    for (int bj = 0; bj < 2; ++bj) { const f32x4 a = acc[ai][bj][m][0], b = acc[ai][bj][m][1];
                        pg8::ssq_put((a.x * a.x + a.y * a.y) + (a.z * a.z + a.w * a.w) + (b.x * b.x + b.y * b.y) + (b.z * b.z + b.w * b.w), ai * 128 + wr * 64 + m * 16 + fr, bj, wc, fq, Pl); }
            EPI_BAR();
            const int gc = (mode == 1 ? (wc & 1) * 32 : wc * 32) + 8 * fq;
            gv[0] = *(const f32x4*)(gain + gc); gv[1] = *(const f32x4*)(gain + gc + 4);
        }
        const unsigned vo = opaque((unsigned)((wr * 64 + fr) * ldc + wc * 32 + 8 * fq) * 2u);
        char* ub = (char*)dst + ((size_t)u.pm * 256 * ldc + col0) * 2;
        const LAS float* qb = Pl + (wr * 64 + fr) * 8;
#pragma unroll
        for (int ai = 0; ai < 2; ++ai)
#pragma unroll
            for (int m = 0; m < 4; ++m) { asm volatile("" : "+v"(acc[ai][0][m][0]), "+v"(acc[ai][0][m][1]), "+v"(acc[ai][1][m][0]), "+v"(acc[ai][1][m][1]) :: "memory"); char* rowp = ub + (size_t)((ai * 128 + m * 16) * ldc) * 2 + vo;
#pragma unroll
                for (int bj = 0; bj < 2; ++bj) { float r = scale;
                    if (mode != 0) { const LAS float* q = qb + (ai * 128 + m * 16) * 8 + bj * 4;
                        float sq; if (mode == 1) sq = (q[wc & 2] + q[(wc & 2) + 1]) * (1.f / 64.f); else sq = ((q[0] + q[1]) + (q[2] + q[3])) * (1.f / 128.f);
                        r = scale * frsq(sq + EPS); }
                    const f32x4 v0 = acc[ai][bj][m][0] * r * gv[0], v1 = acc[ai][bj][m][1] * r * gv[1];
                    u32x4 w; w.x = cvtpk(v0[0], v0[1]); w.y = cvtpk(v0[2], v0[3]); w.z = cvtpk(v1[0], v1[1]); w.w = cvtpk(v1[2], v1[3]);
                    if (skip == 2) asm volatile("" :: "v"(w)); else *(u32x4*)(rowp + bj * 256) = w; } }
        if (mode != 0) EPI_BAR();
    }
};
struct SchedTiles {
    const char* A; const char* B; int nM, nN, lda, ldb, nt, G, c;
    __device__ __forceinline__ bool next(int i, Unit& u) const {
        const int L = i * G + c; if (L >= nM * nN) return false;
        int pm, pn; pg8::tile_of(L, nM, nN, pm, pn); u.A = A + (size_t)pm * 256 * lda * 2; u.B = B + (size_t)pn * 256 * ldb * 2; u.nt = nt; u.pm = pm; u.pn = pn; u.kind = 0; return true;
    }
};
struct EpiGate {
    typedef EpiNoState State;
    bf16_t *OF, *OB, *NMQ; const float* gla_out_g; int skip;
    __device__ __forceinline__ void operator()(f32x4 (&acc)[2][2][4][2], const Unit& u, int wr, int wc, int fr_, int fq_, LAS unsigned char* le, State& est) const {
        if (skip == 1) { _Pragma("unroll") for (int a_ = 0; a_ < 2; ++a_) _Pragma("unroll") for (int m_ = 0; m_ < 4; ++m_) asm volatile("" :: "v"(acc[a_][0][m_][0]), "v"(acc[a_][0][m_][1]), "v"(acc[a_][1][m_][0]), "v"(acc[a_][1][m_][1])); return; }
        const int fr = (int)opaque((unsigned)fr_), fq = (int)opaque((unsigned)fq_);
        const int pn = u.pn; const int cw = wc * 32 + 8 * fq;
        const unsigned vo = opaque((unsigned)((wr * 64 + fr) * 1024 + cw) * 2u);
        if (pn < 4) {
            char* of = (char*)OF + ((size_t)u.pm * 256 * 1024 + pn * 256) * 2; const char* ob = (const char*)OB + ((size_t)u.pm * 256 * 1024 + pn * 256) * 2;
            LAS float* Pl = (LAS float*)le;
            u32x4 tp[8][2];
            u32x4 la[8][2], lb[8][2];
            constexpr int PD = 3;
#pragma unroll
            for (int g = 0; g < PD; ++g)
#pragma unroll
                for (int bj = 0; bj < 2; ++bj) { la[g][bj] = *(const u32x4*)(of + GOFF(g) + bj * 256 + vo); lb[g][bj] = *(const u32x4*)(ob + GOFF(g) + bj * 256 + vo); }
#pragma unroll
            for (int g = 0; g < 8; ++g) { const int ai = g >> 2, m = g & 3;
                asm volatile("" : "+v"(acc[ai][0][m][0]), "+v"(acc[ai][0][m][1]), "+v"(acc[ai][1][m][0]), "+v"(acc[ai][1][m][1]) :: "memory");
                if (g + PD < 8) {
#pragma unroll
                    for (int bj = 0; bj < 2; ++bj) { la[g + PD][bj] = *(const u32x4*)(of + GOFF(g + PD) + bj * 256 + vo); lb[g + PD][bj] = *(const u32x4*)(ob + GOFF(g + PD) + bj * 256 + vo); } }
#pragma unroll
                for (int bj = 0; bj < 2; ++bj) { const u32x4 a = la[g][bj], b = lb[g][bj]; float sq = 0.f; u32x4 tw;
#pragma unroll
                    for (int e = 0; e < 4; ++e) { const float a0 = e < 2 ? acc[ai][bj][m][0][2 * e] : acc[ai][bj][m][1][2 * e - 4], a1 = e < 2 ? acc[ai][bj][m][0][2 * e + 1] : acc[ai][bj][m][1][2 * e - 3];
                        const float lo = bf_lo(a[e]) + bf_lo(b[e]), hi = bf_hi(a[e]) + bf_hi(b[e]); sq += lo * lo + hi * hi; tw[e] = cvtpk(lo * silu_f(a0), hi * silu_f(a1)); }
                    asm volatile("" : "+v"(tw), "+v"(sq));
                    tp[g][bj] = tw;
                    pg8::ssq_put(sq, ai * 128 + wr * 64 + m * 16 + fr, bj, wc, fq, Pl); }
                asm volatile("" ::: "memory"); }
            EPI_BAR();
            const LAS float* qb = Pl + (wr * 64 + fr) * 8; const unsigned vo2 = opaque(vo);
            f32x4 g0v[2], g1v[2];
#pragma unroll
            for (int bj = 0; bj < 2; ++bj) { g0v[bj] = *(const f32x4*)(gla_out_g + bj * 128 + cw); g1v[bj] = *(const f32x4*)(gla_out_g + bj * 128 + cw + 4); }
#pragma unroll
            for (int g = 0; g < 8; ++g) { const int ai = g >> 2, m = g & 3;
                asm volatile("" : "+v"(tp[g][0]), "+v"(tp[g][1]) :: "memory");
                const LAS float* q = qb + (ai * 128 + m * 16) * 8;
                const float rstd = frsq((((q[0] + q[1]) + (q[2] + q[3])) + ((q[4] + q[5]) + (q[6] + q[7]))) * (1.f / 256.f) + EPS);
#pragma unroll
                for (int bj = 0; bj < 2; ++bj) { const u32x4 x = tp[g][bj]; u32x4 w;
#pragma unroll
                    for (int e = 0; e < 4; ++e) { const float g0 = e < 2 ? g0v[bj][2 * e] : g1v[bj][2 * e - 4], g1 = e < 2 ? g0v[bj][2 * e + 1] : g1v[bj][2 * e - 3];
                        w[e] = cvtpk(bf_lo(x[e]) * rstd * g0, bf_hi(x[e]) * rstd * g1); }
                    if (skip == 2) asm volatile("" :: "v"(w)); else *(u32x4*)(of + GOFF(g) + bj * 256 + vo2) = w; }
                asm volatile("" ::: "memory"); }
            EPI_BAR();
        } else {
            char* o = (char*)NMQ + ((size_t)u.pm * 256 * 1024 + (pn - 4) * 256) * 2;
            u32x4 la[8][2]; constexpr int PD = 5;
#pragma unroll
            for (int g = 0; g < PD; ++g)
#pragma unroll
                for (int bj = 0; bj < 2; ++bj) la[g][bj] = *(const u32x4*)(o + GOFF(g) + bj * 256 + vo);
#pragma unroll
            for (int g = 0; g < 8; ++g) { const int ai = g >> 2, m = g & 3;
                asm volatile("" : "+v"(acc[ai][0][m][0]), "+v"(acc[ai][0][m][1]), "+v"(acc[ai][1][m][0]), "+v"(acc[ai][1][m][1]) :: "memory");
                if (g + PD < 8) {
#pragma unroll
                    for (int bj = 0; bj < 2; ++bj) la[g + PD][bj] = *(const u32x4*)(o + GOFF(g + PD) + bj * 256 + vo); }
#pragma unroll
                for (int bj = 0; bj < 2; ++bj) { const u32x4 a = la[g][bj]; u32x4 w;
#pragma unroll
                    for (int e = 0; e < 4; ++e) { const float a0 = e < 2 ? acc[ai][bj][m][0][2 * e] : acc[ai][bj][m][1][2 * e - 4], a1 = e < 2 ? acc[ai][bj][m][0][2 * e + 1] : acc[ai][bj][m][1][2 * e - 3];
                        w[e] = cvtpk(bf_lo(a[e]) * silu_f(a0), bf_hi(a[e]) * silu_f(a1)); }
                    if (skip == 2) asm volatile("" :: "v"(w)); else *(u32x4*)(o + GOFF(g) + bj * 256 + vo) = w; }
                asm volatile("" ::: "memory"); }
        }
    }
};
struct SchedP3 {
    const char *H, *OA, *NMQ, *W; int G, c;
    __device__ __forceinline__ bool next(int i, Unit& u) const {
        const int ti = i / 6, seg = i - ti * 6; const int L = ti * G + c; if (L >= 512) return false;
        int pm, pn; pg8::tile_of(L, 128, 4, pm, pn);
        const char* a; int koff, nt;
        switch (seg) { case 0: a = H; koff = 0; nt = 16; break; case 1: a = OA; koff = 1024; nt = 16; break; case 2: a = H; koff = 2048; nt = 16; break;
                       case 3: a = NMQ; koff = 3072; nt = 8; break; case 4: a = H; koff = 3584; nt = 16; break; default: a = NMQ + 512 * 2; koff = 4608; nt = 8; break; }
        u.A = a + (size_t)pm * 256 * 1024 * 2; u.B = W + ((size_t)pn * 256 * KP3 + koff) * 2; u.nt = nt; u.pm = pm; u.pn = pn; u.kind = seg; return true;
    }
};
struct EpiP3 {
    struct State { u32x2 gc[8][2]; };
    bf16_t* Y;
    __device__ __forceinline__ void operator()(f32x4 (&acc)[2][2][4][2], const Unit& u, int wr, int wc, int fr_, int fq_, LAS unsigned char* le, State& est) const {
        const int fr = (int)opaque((unsigned)fr_), fq = (int)opaque((unsigned)fq_);
        const int seg = u.kind;
        if ((seg & 1) == 0) {
#pragma unroll
            for (int ai = 0; ai < 2; ++ai)
#pragma unroll
                for (int m = 0; m < 4; ++m) { asm volatile("" : "+v"(acc[ai][0][m][0]), "+v"(acc[ai][0][m][1]), "+v"(acc[ai][1][m][0]), "+v"(acc[ai][1][m][1]) :: "memory");
#pragma unroll
                    for (int bj = 0; bj < 2; ++bj) { u32x2 w;
#pragma unroll
                        for (int n = 0; n < 2; ++n) { const f32x4 v = acc[ai][bj][m][n]; unsigned p = 0u;
                            p = __builtin_amdgcn_cvt_pk_u8_f32(sigmoid_f(v[0]) * 255.f, 0, p); p = __builtin_amdgcn_cvt_pk_u8_f32(sigmoid_f(v[1]) * 255.f, 1, p);
                            p = __builtin_amdgcn_cvt_pk_u8_f32(sigmoid_f(v[2]) * 255.f, 2, p); p = __builtin_amdgcn_cvt_pk_u8_f32(sigmoid_f(v[3]) * 255.f, 3, p);
                            w[n] = p; }
                        asm volatile("" : "+v"(w));
                        est.gc[ai * 4 + m][bj] = w; } }
        } else {
            const unsigned vo = opaque((unsigned)((wr * 64 + fr) * 1024 + wc * 32 + 8 * fq) * 2u);
            char* yb = (char*)Y + ((size_t)u.pm * 256 * 1024 + u.pn * 256) * 2;
            u32x4 ly[8][2]; constexpr int PD = 3; constexpr float K = 1.0f / 255.0f;
            if (seg > 1) {
#pragma unroll
                for (int g = 0; g < PD; ++g)
#pragma unroll
                    for (int bj = 0; bj < 2; ++bj) ly[g][bj] = *(const u32x4*)(yb + GOFF(g) + bj * 256 + vo); }
#pragma unroll
            for (int g = 0; g < 8; ++g) { const int ai = g >> 2, m = g & 3;
                asm volatile("" : "+v"(acc[ai][0][m][0]), "+v"(acc[ai][0][m][1]), "+v"(acc[ai][1][m][0]), "+v"(acc[ai][1][m][1]), "+v"(est.gc[g][0]), "+v"(est.gc[g][1]) :: "memory");
#pragma unroll
                for (int bj = 0; bj < 2; ++bj) { const unsigned a0 = est.gc[g][bj][0], a1 = est.gc[g][bj][1]; const f32x4 v0 = acc[ai][bj][m][0], v1 = acc[ai][bj][m][1];
                    float o[8] = {v0[0] * ((float)(a0 & 0xffu) * K), v0[1] * ((float)((a0 >> 8) & 0xffu) * K), v0[2] * ((float)((a0 >> 16) & 0xffu) * K), v0[3] * ((float)(a0 >> 24) * K),
                                  v1[0] * ((float)(a1 & 0xffu) * K), v1[1] * ((float)((a1 >> 8) & 0xffu) * K), v1[2] * ((float)((a1 >> 16) & 0xffu) * K), v1[3] * ((float)(a1 >> 24) * K)};
                    if (seg > 1) { const u32x4 p = ly[g][bj];
                        o[0] += bf_lo(p.x); o[1] += bf_hi(p.x); o[2] += bf_lo(p.y); o[3] += bf_hi(p.y); o[4] += bf_lo(p.z); o[5] += bf_hi(p.z); o[6] += bf_lo(p.w); o[7] += bf_hi(p.w); }
                    u32x4 w; w.x = cvtpk(o[0], o[1]); w.y = cvtpk(o[2], o[3]); w.z = cvtpk(o[4], o[5]); w.w = cvtpk(o[6], o[7]);
                    *(u32x4*)(yb + GOFF(g) + bj * 256 + vo) = w; }
                if (seg > 1 && g + PD < 8) {
#pragma unroll
                    for (int bj = 0; bj < 2; ++bj) ly[g + PD][bj] = *(const u32x4*)(yb + GOFF(g + PD) + bj * 256 + vo); }
                asm volatile("" ::: "memory"); }
        }
    }
};
struct EpiP4 {
    typedef EpiNoState State;
    const float* xin; float* out;
    __device__ __forceinline__ void operator()(f32x4 (&acc)[2][2][4][2], const Unit& u, int wr, int wc, int fr_, int fq_, LAS unsigned char* le, State& est) const {
        const int fr = (int)opaque((unsigned)fr_), fq = (int)opaque((unsigned)fq_);
        const unsigned vo = opaque((unsigned)((wr * 64 + fr) * 1024 + wc * 32 + 8 * fq) * 4u);
        const size_t ubo = ((size_t)u.pm * 256 * 1024 + u.pn * 256) * 4; const char* xb = (const char*)xin + ubo; char* ob = (char*)out + ubo;
        f32x4 lx[8][2][2]; constexpr int PD = 3;
#pragma unroll
        for (int g = 0; g < PD; ++g)
#pragma unroll
            for (int bj = 0; bj < 2; ++bj)
#pragma unroll
                for (int n = 0; n < 2; ++n) lx[g][bj][n] = *(const f32x4*)(xb + 2 * GOFF(g) + vo + bj * 512 + 16 * n);
#pragma unroll
        for (int g = 0; g < 8; ++g) { const int ai = g >> 2, m = g & 3;
            asm volatile("" : "+v"(acc[ai][0][m][0]), "+v"(acc[ai][0][m][1]), "+v"(acc[ai][1][m][0]), "+v"(acc[ai][1][m][1]) :: "memory");
#pragma unroll
            for (int bj = 0; bj < 2; ++bj)
#pragma unroll
                for (int n = 0; n < 2; ++n) *(f32x4*)(ob + 2 * GOFF(g) + vo + bj * 512 + 16 * n) = lx[g][bj][n] + acc[ai][bj][m][n];
            if (g + PD < 8) {
#pragma unroll
                for (int bj = 0; bj < 2; ++bj)
#pragma unroll
                    for (int n = 0; n < 2; ++n) lx[g + PD][bj][n] = *(const f32x4*)(xb + 2 * GOFF(g + PD) + vo + bj * 512 + 16 * n); }
            asm volatile("" ::: "memory"); }
    }
};

__device__ __forceinline__ void glaprep_phase(const Ptrs& P, int l, LAS unsigned char* lds, int bx, int G, const int wv, const int probe) {
    const int tid = tid_of(wv), lane = tid & 63, w = __builtin_amdgcn_readfirstlane(tid >> 6), li = lane & 15, q4 = lane >> 4;
    constexpr int PSTR = 132, PTAB = 64 * PSTR * 4;
    const int st_tok = 8 * w + (lane >> 3), st_c = lane & 7;
    const unsigned lo_row = (unsigned)(st_tok * 1024 + st_c * 16);
    const unsigned lo_g = (unsigned)(li * 64 + 8 * q4) * 2u;
    char* GQb = (char*)(P.ws + WS_GQ); char* GKb = (char*)(P.ws + WS_GK); char* QBb = (char*)(P.ws + WS_QEB); char* KBb = (char*)(P.ws + WS_KEB);
    char* QFb = probe ? QBb : GQb; char* KFb = probe ? KBb : GKb;
    const char* GLb = (const char*)(P.ws + WS_GLR);
    float* DEC = (float*)(P.ws + WS_DEC);
#define PRE_S1(ga_, w2B_, bk_, BCd_, decp_, REV) do { f32x4 z_[4]; \
        _Pragma("unroll") for (int tt = 0; tt < 4; ++tt) z_[tt] = mfma16(ga_[tt], w2B_, (f32x4){bk_, bk_, bk_, bk_}); \
        float off_ = 0.f; float pv_[4][4]; \
        _Pragma("unroll") for (int tt = 0; tt < 4; ++tt) { float v_[4]; float run_ = 0.f; \
            _Pragma("unroll") for (int r = 0; r < 4; ++r) { const float zz = z_[tt][r]; const float ls2 = fminf(zz, 0.f) * LOG2E - __builtin_amdgcn_logf(1.f + fexp2(-fabsf(zz) * LOG2E)); \
                if (REV) v_[r] = run_; run_ += ls2 * (1.f / 16.f); if (!(REV)) v_[r] = run_; } \
            float s1_ = run_; { const float u_ = bperm(s1_, (lane - 16) & 63); if (q4 >= 1) s1_ += u_; } \
            { const float u_ = bperm(s1_, (lane - 32) & 63); if (q4 >= 2) s1_ += u_; } \
            const float excl_ = s1_ - run_; const float tot_ = bperm(s1_, 48 + li); \
            _Pragma("unroll") for (int r = 0; r < 4; ++r) pv_[tt][r] = off_ + excl_ + v_[r]; \
            off_ += tot_; } \
        _Pragma("unroll") for (int tt = 0; tt < 4; ++tt) _Pragma("unroll") for (int r = 0; r < 4; ++r) BCd_[(16 * tt + 4 * q4 + r) * PSTR + 16 * w + li] = (REV) ? off_ - pv_[tt][r] : pv_[tt][r]; \
        if (q4 == 0) (decp_)[16 * w + li] = fexp2(off_); } while (0)
#define PRE_S2(BCd_, QEd_, KEd_) do { \
        _Pragma("unroll") for (int p_ = 0; p_ < 2; ++p_) { const LAS f32x4* bp = (const LAS f32x4*)(BCd_ + st_tok * PSTR + (st_c + 8 * p_) * 8); \
            const f32x4 b0 = bp[0], b1 = bp[1]; u32x4 qe, ke; \
            _Pragma("unroll") for (int e = 0; e < 4; ++e) { const float bl = e < 2 ? b0[2 * e] : b1[2 * e - 4], bh_ = e < 2 ? b0[2 * e + 1] : b1[2 * e - 3]; \
                const float el = fexp2(bl), eh = fexp2(bh_), il = fexp2(-bl), ih = fexp2(-bh_); \
                qe[e] = cvtpk(bf_lo(qv[p_][e]) * el, bf_hi(qv[p_][e]) * eh); ke[e] = cvtpk(bf_lo(kv[p_][e]) * il, bf_hi(kv[p_][e]) * ih); } \
            *(u32x4*)((QEd_) + uo + (size_t)p_ * 128 + lo_row) = qe; *(u32x4*)((KEd_) + uo + (size_t)p_ * 128 + lo_row) = ke; } } while (0)
    int par = 0;
#pragma unroll 1
    for (int u = bx; u < NB * 4 * 64; u += G) {
        const int ca = u & 63, h = (u >> 6) & 3, b = u >> 8;
        LAS float* BC0 = (LAS float*)(lds + par * 2 * PTAB); LAS float* BC1 = (LAS float*)(lds + par * 2 * PTAB + PTAB); par ^= 1;
        const float* w2f = P.w2f + (size_t)l * 16 * 512 + h * 128; const float* w2b = P.w2b + (size_t)l * 16 * 512 + h * 128;
        bf16x8 w2Bf, w2Bb; { unsigned pf[4], pb[4];
#pragma unroll
            for (int e = 0; e < 4; ++e) { const int r0 = (8 * q4 + 2 * e) & 15; pf[e] = cvtpk(w2f[r0 * 512 + 16 * w + li], w2f[(r0 + 1) * 512 + 16 * w + li]); pb[e] = cvtpk(w2b[r0 * 512 + 16 * w + li], w2b[(r0 + 1) * 512 + 16 * w + li]); }
            const u32x4 tf = {pf[0], pf[1], pf[2], pf[3]}, tb = {pb[0], pb[1], pb[2], pb[3]}; w2Bf = __builtin_bit_cast(bf16x8, tf); w2Bb = __builtin_bit_cast(bf16x8, tb); }
        const float bkf = P.bf[(size_t)l * 512 + h * 128 + 16 * w + li], bkb = P.bb[(size_t)l * 512 + h * 128 + 16 * w + li];
        const size_t tok0 = (size_t)b * SEQ + ca * 64;
        const size_t uo = tok0 * 1024 + h * 256;
        bf16x8 gaf[4], gab[4]; u32x4 qv[2], kv[2];
#pragma unroll
        for (int tt = 0; tt < 4; ++tt) { gaf[tt] = *(const bf16x8*)(GLb + (tok0 + 16 * tt) * 128 + lo_g); gab[tt] = *(const bf16x8*)(GLb + (tok0 + 16 * tt) * 128 + 64 + lo_g); }
#pragma unroll
        for (int p_ = 0; p_ < 2; ++p_) { qv[p_] = *(const u32x4*)(GQb + uo + (size_t)p_ * 128 + lo_row); kv[p_] = *(const u32x4*)(GKb + uo + (size_t)p_ * 128 + lo_row); }
        float* decf = DEC + ((size_t)((0 * NB + b) * 4 + h) * 64 + ca) * 128; float* decb = DEC + ((size_t)((1 * NB + b) * 4 + h) * 64 + ca) * 128;
        PRE_S1(gaf, w2Bf, bkf, BC0, decf, 0);
        PRE_S1(gab, w2Bb, bkb, BC1, decb, 1);
        asm volatile("s_waitcnt lgkmcnt(0)" ::: "memory"); __builtin_amdgcn_s_barrier(); asm volatile("" ::: "memory");
        PRE_S2(BC0, QFb, KFb);
        PRE_S2(BC1, QBb, KBb);
    }
#undef PRE_S1
#undef PRE_S2
}

constexpr int GL_BUF = 41984, GL_KEO = 16384, GL_VO = 32768, GL_DECO = 40960, GL_SB = 2 * GL_BUF, GL_XCH = GL_SB + 2 * 16384;
static_assert(GL_XCH + 2 * 8192 <= LDS_CTLW, "gla lds");
__device__ __forceinline__ int sw256(int row, int c) { return row * 256 + ((c ^ (row & 15)) << 4); }
__device__ __forceinline__ int sw128v(int row, int c) { return row * 128 + ((c ^ (((row >> 1) & 3) << 1)) << 4); }
__device__ __forceinline__ int sw128s(int row, int c) { return row * 128 + ((c ^ ((((row >> 1) & 1) | (((row >> 3) & 1) << 1)) << 1)) << 4); }
#define BAR_LDS() do { asm volatile("s_waitcnt lgkmcnt(0)" ::: "memory"); __builtin_amdgcn_s_barrier(); asm volatile("" ::: "memory"); } while (0)
__device__ __forceinline__ void gla_item(const Ptrs& P, int l, int item, LAS unsigned char* lds, const int wv) {
    const int tid = tid_of(wv), lane = tid & 63, w = __builtin_amdgcn_readfirstlane(tid >> 6), li = lane & 15, q4 = lane >> 4;
    const int xcd = item & 7, idx = item >> 3, bh = xcd * 4 + (idx >> 3), sub = idx & 7, j = sub & 3, dir = sub >> 2;
    const int b = bh >> 2, h = bh & 3;
    const char* QEb = (const char*)(P.ws + (dir ? WS_QEB : WS_GQ)) + ((size_t)b * SEQ * 512 + h * 128) * 2;
    const char* KEb = (const char*)(P.ws + (dir ? WS_KEB : WS_GK)) + ((size_t)b * SEQ * 512 + h * 128) * 2;
    const char* GVb = (const char*)(P.ws + WS_GV) + ((size_t)b * SEQ * 1024 + h * 256 + j * 64) * 2;
    char* Ob = (char*)(P.ws + (dir ? WS_OBW : WS_OF)) + ((size_t)b * SEQ * 1024 + h * 256 + j * 64) * 2;
    const float* DECb = (const float*)(P.ws + WS_DEC) + ((size_t)((dir * NB + b) * 4 + h) * 64) * 128;
    f32x4 ST[4];
#pragma unroll
    for (int k = 0; k < 4; ++k) ST[k] = (f32x4){0.f, 0.f, 0.f, 0.f};
    { LAS u32x4* z = (LAS u32x4*)(lds + GL_SB + 16384); const unsigned zz = opaque(0u); z[tid] = (u32x4){zz, zz, zz, zz}; z[tid + 512] = (u32x4){zz, zz, zz, zz}; }
    const int it = w >> 1, dt0 = (w & 1) * 2;
    const int sdt = w & 3, kt0 = (w >> 2) * 4;
    unsigned lo_d[2], lo_dv;
#pragma unroll
    for (int e = 0; e < 2; ++e) { const int tk = 8 * w + 4 * e + (lane >> 4), c16 = (lane & 15) ^ (tk & 15); lo_d[e] = (unsigned)((dir ? 63 - tk : tk) * 1024 + c16 * 16); }
    { const int row = 8 * w + (lane >> 3), c = (lane & 7) ^ (((row >> 1) & 3) << 1); lo_dv = (unsigned)((dir ? 63 - row : row) * 2048 + c * 16); }
#define GLA_DMA1(gb, vo, la) asm volatile("s_mov_b32 m0, %0\n\ts_nop 0\n\tglobal_load_lds_dwordx4 %1, %2" :: "s"((unsigned)(__UINTPTR_TYPE__)(la)), "v"(vo), "s"(gb) : "m0", "memory")
    const int dq0 = w == 1 ? 0 : w == 3 ? 4 : w == 0 ? 8 : w == 5 ? 9 : w == 2 ? 11 : w == 4 ? 12 : w == 6 ? 13 : 15;
    const int dqn = (w == 1 || w == 3) ? 4 : (w == 5 || w == 6) ? 2 : 1;
    const int dv0 = w == 0 ? 0 : w == 5 ? 1 : w == 2 ? 2 : w == 4 ? 4 : 6;
    const int dvn = (w == 1 || w == 3 || w == 6) ? 0 : (w == 0 || w == 5) ? 1 : 2;
#define GLA_DMA(cc, bo) do { const size_t ca_ = (size_t)(dir ? 63 - (cc) : (cc)) * 64; \
        for (int k_ = 0; k_ < dqn; ++k_) { const int i_ = dq0 + k_; const int tk_ = 4 * i_ + (lane >> 4); const unsigned o_ = (unsigned)((dir ? 63 - tk_ : tk_) * 1024 + (((lane & 15) ^ (tk_ & 15)) << 4)); \
            GLA_DMA1(QEb + ca_ * 1024, o_, lds + (bo) + i_ * 1024); GLA_DMA1(KEb + ca_ * 1024, o_, lds + (bo) + GL_KEO + i_ * 1024); } \
        for (int k_ = 0; k_ < dvn; ++k_) { const int i_ = dv0 + k_; const int row_ = 8 * i_ + (lane >> 3); const unsigned o_ = (unsigned)((dir ? 63 - row_ : row_) * 2048 + (((lane & 7) ^ (((row_ >> 1) & 3) << 1)) << 4)); \
            GLA_DMA1(GVb + ca_ * 2048, o_, lds + (bo) + GL_VO + i_ * 1024); } \
        if (w == 0) { unsigned long long sv_; asm volatile("s_mov_b64 %0, exec\n\ts_mov_b64 exec, 0xffffffff\n\ts_mov_b32 m0, %1\n\ts_nop 0\n\tglobal_load_lds_dwordx4 %2, %3\n\ts_mov_b64 exec, %0" \
            : "=&s"(sv_) : "s"((unsigned)(__UINTPTR_TYPE__)(lds + (bo) + GL_DECO)), "v"((unsigned)lane * 16u), "s"((const char*)DECb + ca_ * 8) : "m0", "memory"); } } while (0)
    GLA_DMA(0, 0);
    asm volatile("s_waitcnt vmcnt(0)" ::: "memory");
    __builtin_amdgcn_s_waitcnt(0x0F70);
    BAR_LDS();
    const int trr = (li >> 2), trc = ((li & 3) >> 1), trs = (li & 1) * 8;
    const int hf = w & 1; const bool act1 = 2 * hf <= it, act2 = 2 * hf + 1 <= it;
    const unsigned lo_o = (unsigned)((dir ? 63 - (16 * it + li) : 16 * it + li) * 1024 + 16 * dt0) * 2u + 16u * (unsigned)q4;
    f32x4 OTk[2] = {(f32x4){0.f, 0.f, 0.f, 0.f}, (f32x4){0.f, 0.f, 0.f, 0.f}};
#define GLA_FINAL(cc, xo) do { const u32x4 xp = *(const LAS u32x4*)(lds + GL_XCH + (xo) + (w ^ 1) * 1024 + lane * 16); \
          const size_t cb = (size_t)(dir ? 63 - (cc) : (cc)) * 64; u32x2 ov0, ov1; \
          ov0.x = cvtpk(OTk[0][0] + bf_lo(xp.x), OTk[0][1] + bf_hi(xp.x)); ov0.y = cvtpk(OTk[0][2] + bf_lo(xp.y), OTk[0][3] + bf_hi(xp.y)); \
          ov1.x = cvtpk(OTk[1][0] + bf_lo(xp.z), OTk[1][1] + bf_hi(xp.z)); ov1.y = cvtpk(OTk[1][2] + bf_lo(xp.w), OTk[1][3] + bf_hi(xp.w)); \
            \
          { auto r0 = __builtin_amdgcn_permlane32_swap(ov0.x, ov1.x, false, false); auto r1 = __builtin_amdgcn_permlane32_swap(ov0.y, ov1.y, false, false); \
            auto s0 = __builtin_amdgcn_permlane16_swap(r0[0], r0[1], false, false); auto s1 = __builtin_amdgcn_permlane16_swap(r1[0], r1[1], false, false); \
            const u32x4 ow = {s0[0], s1[0], s0[1], s1[1]}; *(u32x4*)(Ob + cb * 2048 + lo_o) = ow; } } while (0)
#pragma unroll 1
    for (int c2 = 0; c2 < 32; ++c2) {
#pragma unroll
      for (int sb = 0; sb < 2; ++sb) { const int c = 2 * c2 + sb; const int BO = sb * GL_BUF, SBR = GL_SB + (sb ^ 1) * 16384, SBW = GL_SB + sb * 16384, XR = (sb ^ 1) * 8192, XW = sb * 8192;
        if (c + 1 < 64) GLA_DMA(c + 1, (sb ^ 1) * GL_BUF);
        bf16x8 qb[4]; s16x4 sa[2][4][2]; s16x4 vi[4][2]; s16x4 vm[2][2]; s16x4 kb[4][2][2]; float dec[4]; bf16x8 ka1[4], ka2[4];
#pragma unroll
        for (int s = 0; s < 4; ++s) qb[s] = *(const LAS bf16x8*)(lds + BO + sw256(16 * it + li, 4 * s + q4));
#pragma unroll
        for (int dd = 0; dd < 2; ++dd)
#pragma unroll
            for (int s = 0; s < 4; ++s) { const int r0 = 32 * s + 8 * q4 + trr; const int cc = 2 * (dt0 + dd) + trc;
                sa[dd][s][0] = tr_read(lds + SBR + sw128s(r0, cc) + trs); sa[dd][s][1] = tr_read(lds + SBR + sw128s(r0 + 4, cc) + trs); }
        if (act1) {
#pragma unroll
            for (int s = 0; s < 4; ++s) ka1[s] = *(const LAS bf16x8*)(lds + BO + GL_KEO + sw256(32 * hf + li, 4 * s + q4)); }
        if (act2) {
#pragma unroll
            for (int s = 0; s < 4; ++s) ka2[s] = *(const LAS bf16x8*)(lds + BO + GL_KEO + sw256(32 * hf + 16 + li, 4 * s + q4)); }
        if (c > 0) GLA_FINAL(c - 1, XR);
        __builtin_amdgcn_sched_barrier(0);
        f32x4 OT[2] = {(f32x4){0.f, 0.f, 0.f, 0.f}, (f32x4){0.f, 0.f, 0.f, 0.f}};
#pragma unroll
        for (int s = 0; s < 4; ++s)
#pragma unroll
            for (int dd = 0; dd < 2; ++dd) OT[dd] = mfma16(cat44(sa[dd][s][0], sa[dd][s][1]), qb[s], OT[dd]);
        unsigned pk1[2] = {0u, 0u}, pk2[2] = {0u, 0u};
        if (act1) { f32x4 at = (f32x4){0.f, 0.f, 0.f, 0.f};
#pragma unroll
            for (int s = 0; s < 4; ++s) at = mfma16(ka1[s], qb[s], at);
            if (2 * hf == it) {
#pragma unroll
                for (int r = 0; r < 4; ++r) if (4 * q4 + r > li) at[r] = 0.f; }
            pk1[0] = cvtpk(at[0], at[1]); pk1[1] = cvtpk(at[2], at[3]); }
        if (act2) { f32x4 at = (f32x4){0.f, 0.f, 0.f, 0.f};
#pragma unroll
            for (int s = 0; s < 4; ++s) at = mfma16(ka2[s], qb[s], at);
            if (2 * hf + 1 == it) {
#pragma unroll
                for (int r = 0; r < 4; ++r) if (4 * q4 + r > li) at[r] = 0.f; }
            pk2[0] = cvtpk(at[0], at[1]); pk2[1] = cvtpk(at[2], at[3]); }
#pragma unroll
        for (int s = 0; s < 2; ++s) { const int r0 = 32 * s + 4 * q4 + trr; const int cc = 2 * sdt + trc;
            vm[s][0] = tr_read(lds + BO + GL_VO + sw128v(r0, cc) + trs); vm[s][1] = tr_read(lds + BO + GL_VO + sw128v(r0 + 16, cc) + trs); }
#pragma unroll
        for (int kk = 0; kk < 4; ++kk) { const int kt = kt0 + kk; dec[kk] = *(const LAS float*)(lds + BO + GL_DECO + (16 * kt + li) * 4);
#pragma unroll
            for (int s = 0; s < 2; ++s) { const int r0 = 32 * s + 4 * q4 + trr; const int cc = 2 * kt + trc;
                kb[kk][s][0] = tr_read(lds + BO + GL_KEO + sw256(r0, cc) + trs); kb[kk][s][1] = tr_read(lds + BO + GL_KEO + sw256(r0 + 16, cc) + trs); } }
        if (act1) {
#pragma unroll
            for (int dt = 0; dt < 4; ++dt) { const int r0 = 32 * hf + 4 * q4 + trr; const int cc = 2 * dt + trc;
                vi[dt][0] = tr_read(lds + BO + GL_VO + sw128v(r0, cc) + trs); vi[dt][1] = tr_read(lds + BO + GL_VO + sw128v(r0 + 16, cc) + trs); } }
        __builtin_amdgcn_sched_barrier(0);
#pragma unroll
        for (int kk = 0; kk < 4; ++kk) {
#pragma unroll
            for (int s = 0; s < 2; ++s) ST[kk] = mfma16(cat44(vm[s][0], vm[s][1]), cat44(kb[kk][s][0], kb[kk][s][1]), ST[kk]);
            ST[kk] = ST[kk] * dec[kk]; }
        f32x4 IP[4] = {(f32x4){0.f, 0.f, 0.f, 0.f}, (f32x4){0.f, 0.f, 0.f, 0.f}, (f32x4){0.f, 0.f, 0.f, 0.f}, (f32x4){0.f, 0.f, 0.f, 0.f}};
        if (act1) { const u32x4 bw = {pk1[0], pk1[1], pk2[0], pk2[1]}; const bf16x8 bfr = __builtin_bit_cast(bf16x8, bw);
#pragma unroll
            for (int dt = 0; dt < 4; ++dt) IP[dt] = mfma16(cat44(vi[dt][0], vi[dt][1]), bfr, IP[dt]); }
        { const f32x4 s0 = hf ? IP[0] : IP[2], s1 = hf ? IP[1] : IP[3];
          const u32x4 xw = {cvtpk(s0[0], s0[1]), cvtpk(s0[2], s0[3]), cvtpk(s1[0], s1[1]), cvtpk(s1[2], s1[3])};
          *(LAS u32x4*)(lds + GL_XCH + XW + w * 1024 + lane * 16) = xw; }
        OTk[0] = OT[0] + (hf ? IP[2] : IP[0]); OTk[1] = OT[1] + (hf ? IP[3] : IP[1]);
#pragma unroll
        for (int kk = 0; kk < 4; ++kk) { const int kr = 16 * (kt0 + kk) + li; u32x2 sv; sv.x = cvtpk(ST[kk][0], ST[kk][1]); sv.y = cvtpk(ST[kk][2], ST[kk][3]);
            *(LAS u32x2*)(lds + SBW + sw128s(kr, 2 * sdt + (q4 >> 1)) + (q4 & 1) * 8) = sv; }
        if (c > 0) asm volatile("s_waitcnt vmcnt(1)" ::: "memory"); else asm volatile("s_waitcnt vmcnt(0)" ::: "memory");
        BAR_LDS();
      }
    }
    GLA_FINAL(63, 8192);
#undef GLA_FINAL
#undef GLA_DMA1
#undef GLA_DMA
}

constexpr int NA_K = 0, NA_V = 73728, NA_RPB = 147456, NA_XCH = 149504;
__device__ __forceinline__ int swk128(int row, int c) { return row * 128 + ((c ^ ((row >> 1) & 7)) << 4); }
__device__ __forceinline__ int swv128(int row, int c) { return row * 128 + ((c ^ (row & 6)) << 4); }
__device__ __forceinline__ void na_item(const Ptrs& P, int l, int item, LAS unsigned char* lds, const int wv, bool do_store = true) {
    const int tid = tid_of(wv), lane = tid & 63, w = __builtin_amdgcn_readfirstlane(tid >> 6), li = lane & 15, q4 = lane >> 4;
    const int rg = item & 3, h = (item >> 2) & 7, b = item >> 5;
    const int r0 = rg * 16;
    const int t = w & 3, dh = w >> 2;
    const int c0 = t == 0 ? 0 : (t == 1 ? 8 : (t == 2 ? 24 : 32));
    char* NMQb = (char*)(P.ws + WS_NMQ) + ((size_t)b * SEQ * 1024 + h * 64) * 2;
    const char* NKb = (const char*)(P.ws + WS_NK) + ((size_t)b * SEQ * 512 + h * 64) * 2; const char* NVb = (const char*)(P.ws + WS_NV) + ((size_t)b * SEQ * 512 + h * 64) * 2;
    const int qc = 16 * t + li;
    const unsigned lo_q = (unsigned)(qc * 1024 + 8 * q4) * 2u;
    const unsigned lo_o = (unsigned)(qc * 1024 + 32 * dh) * 2u + 16u * (unsigned)q4;
    const int fk = tid >> 3, fc = tid & 7;
    const unsigned lo_f = (unsigned)(fk * 512 + fc * 8) * 2u;
    int rs = min(max(r0 - 4, 0), 56);
    struct NaPre { bf16x8 q[2]; u32x4 kv, vv; };
    NaPre S0, S1, S2;
#define NA_ISSUE(S, rr) do { const int rq_ = min((rr), 63); const int rk_ = min(max(rq_ - 4, 0), 56) + 7; \
        _Pragma("unroll") for (int s = 0; s < 2; ++s) (S).q[s] = *(const bf16x8*)(NMQb + (size_t)rq_ * 64 * 2048 + lo_q + s * 64); \
        (S).kv = *(const u32x4*)(NKb + (size_t)rk_ * 64 * 1024 + lo_f); (S).vv = *(const u32x4*)(NVb + (size_t)rk_ * 64 * 1024 + lo_f); } while (0)
    NA_ISSUE(S0, r0);
#pragma unroll
    for (int i = 0; i < 8; ++i) { const int ar = rs + i; const int slot = ar % 9; const size_t ro = (size_t)ar * 64 * 1024;
        const u32x4 kv = *(const u32x4*)(NKb + ro + lo_f), vv = *(const u32x4*)(NVb + ro + lo_f);
        *(LAS u32x4*)(lds + NA_K + slot * 8192 + swk128(fk, fc)) = kv; *(LAS u32x4*)(lds + NA_V + slot * 8192 + swv128(fk, fc)) = vv; }
    LAS float* RP = (LAS float*)(lds + NA_RPB);
    if (tid < 465) RP[tid] = P.rpb[((size_t)l * 8 + h) * 465 + tid] * LOG2E;
    asm volatile("s_waitcnt vmcnt(0)" ::: "memory");
    BAR_LDS();
    NA_ISSUE(S1, r0 + 1);
    const int cs = min(max(qc - 8, 0), 48);
    const int trr = li >> 2, trc = (li & 3) >> 1, trs = (li & 1) * 8;
    const int bh = dh;
    float bc_[4][2][4]; int cur_off = 1000;
    LAS unsigned char* xo_mine = lds + NA_XCH + w * 1024 + lane * 16; LAS unsigned char* xr_mine = lds + NA_XCH + 8192 + w * 256 + lane * 4;
    const LAS unsigned char* xo_part = lds + NA_XCH + (w ^ 4) * 1024 + lane * 16; const LAS unsigned char* xr_part = lds + NA_XCH + 8192 + (w ^ 4) * 256 + lane * 4;
    auto step = [&](NaPre& C, NaPre& A, NaPre& B, const int i) __attribute__((always_inline)) {
        const int r = r0 + i;
        if (rs - r != cur_off) { cur_off = rs - r;
#pragma unroll
            for (int sp = 0; sp < 4; ++sp) { const int drow = (cur_off + 4 * bh + sp + 7) * 31;
#pragma unroll
                for (int e = 0; e < 2; ++e)
#pragma unroll
                    for (int rr = 0; rr < 4; ++rr) { const int kcol = c0 + 16 * e + 4 * q4 + rr; const bool ok = (kcol >= cs) && (kcol < cs + 16);
                        const int dc = min(max(kcol - qc + 15, 0), 30); const float b_ = RP[drow + dc]; bc_[sp][e][rr] = ok ? b_ : -1e30f; } } }
        const int rsn = min(max(r + 1 - 4, 0), 56); const bool newrow = (i < 15) && (rsn != rs);
        NA_ISSUE(B, r + 2);
        f32x4 OT[4] = {(f32x4){0.f, 0.f, 0.f, 0.f}, (f32x4){0.f, 0.f, 0.f, 0.f}, (f32x4){0.f, 0.f, 0.f, 0.f}, (f32x4){0.f, 0.f, 0.f, 0.f}}; float rsum = 0.f;
        bf16x8 ka[4][2][2]; s16x4 va[4][4][2];
        { int slot = (rs + 4 * bh) % 9; int slots[4];
#pragma unroll
          for (int sp = 0; sp < 4; ++sp) { slots[sp] = slot; slot = slot == 8 ? 0 : slot + 1; }
#pragma unroll
          for (int sp = 0; sp < 4; ++sp) { const LAS unsigned char* kb_ = lds + NA_K + slots[sp] * 8192;
#pragma unroll
            for (int e = 0; e < 2; ++e)
#pragma unroll
                for (int s = 0; s < 2; ++s) ka[sp][e][s] = *(const LAS bf16x8*)(kb_ + swk128(c0 + 16 * e + li, 4 * s + q4)); }
#pragma unroll
          for (int sp = 0; sp < 4; ++sp) { const LAS unsigned char* vb_ = lds + NA_V + slots[sp] * 8192;
#pragma unroll
            for (int dt = 0; dt < 4; ++dt) { const int k0r = c0 + 4 * q4 + trr; const int cc = 2 * dt + trc;
                va[sp][dt][0] = tr_read(vb_ + swv128(k0r, cc) + trs); va[sp][dt][1] = tr_read(vb_ + swv128(k0r + 16, cc) + trs); } } }
        __builtin_amdgcn_sched_barrier(0);
#pragma unroll
        for (int sp = 0; sp < 4; ++sp) {
            unsigned pk[2][2];
#pragma unroll
            for (int e = 0; e < 2; ++e) { f32x4 sc = (f32x4){0.f, 0.f, 0.f, 0.f};
#pragma unroll
                for (int s = 0; s < 2; ++s) sc = mfma16(ka[sp][e][s], C.q[s], sc);
                float p[4];
#pragma unroll
                for (int rr = 0; rr < 4; ++rr) { p[rr] = fexp2(sc[rr] + bc_[sp][e][rr]); rsum += p[rr]; }
                pk[e][0] = cvtpk(p[0], p[1]); pk[e][1] = cvtpk(p[2], p[3]); }
            const u32x4 bw = {pk[0][0], pk[0][1], pk[1][0], pk[1][1]}; const bf16x8 bfr = __builtin_bit_cast(bf16x8, bw);
#pragma unroll
            for (int dt = 0; dt < 4; ++dt) OT[dt] = mfma16(cat44(va[sp][dt][0], va[sp][dt][1]), bfr, OT[dt]);
        }
        rsum += bperm(rsum, lane ^ 16); rsum += bperm(rsum, lane ^ 32);
        { const f32x4 s0 = bh ? OT[0] : OT[2], s1 = bh ? OT[1] : OT[3];
          const u32x4 xw = {cvtpk(s0[0], s0[1]), cvtpk(s0[2], s0[3]), cvtpk(s1[0], s1[1]), cvtpk(s1[2], s1[3])};
          *(LAS u32x4*)xo_mine = xw; *(LAS float*)xr_mine = rsum; }
        BAR_LDS();
        const u32x4 xp = *(const LAS u32x4*)xo_part; const float rtot = rsum + *(const LAS float*)xr_part;
        const f32x4 m0 = bh ? OT[2] : OT[0], m1 = bh ? OT[3] : OT[1];
        const float inv = frcp(rtot);
        u32x2 ov0, ov1;
        ov0.x = cvtpk((m0[0] + bf_lo(xp.x)) * inv, (m0[1] + bf_hi(xp.x)) * inv); ov0.y = cvtpk((m0[2] + bf_lo(xp.y)) * inv, (m0[3] + bf_hi(xp.y)) * inv);
        ov1.x = cvtpk((m1[0] + bf_lo(xp.z)) * inv, (m1[1] + bf_hi(xp.z)) * inv); ov1.y = cvtpk((m1[2] + bf_lo(xp.w)) * inv, (m1[3] + bf_hi(xp.w)) * inv);
        if (newrow) { const int slot_n = (rs + 8) % 9; *(LAS u32x4*)(lds + NA_K + slot_n * 8192 + swk128(fk, fc)) = A.kv; *(LAS u32x4*)(lds + NA_V + slot_n * 8192 + swv128(fk, fc)) = A.vv; }
        { auto r0 = __builtin_amdgcn_permlane32_swap(ov0.x, ov1.x, false, false); auto r1 = __builtin_amdgcn_permlane32_swap(ov0.y, ov1.y, false, false);
          auto s0 = __builtin_amdgcn_permlane16_swap(r0[0], r0[1], false, false); auto s1 = __builtin_amdgcn_permlane16_swap(r1[0], r1[1], false, false);
          const u32x4 ow = {s0[0], s1[0], s0[1], s1[1]};
          if (do_store) *(u32x4*)(NMQb + (size_t)r * 64 * 2048 + lo_o) = ow; else asm volatile("" :: "v"(ow)); }
        BAR_LDS();
        rs = rsn;
    };
#pragma unroll 1
    for (int i3 = 0; i3 < 15; i3 += 3) { step(S0, S1, S2, i3); step(S1, S2, S0, i3 + 1); step(S2, S0, S1, i3 + 2); }
    step(S0, S1, S2, 15);
#undef NA_ISSUE
}

constexpr int MA_K = 0, MA_V = 65536;
__device__ __forceinline__ int swm(int row, int c) { return row * 256 + ((c ^ (row & 15)) << 4); }
__device__ __forceinline__ int swmv(int row, int c) { return row * 256 + ((c ^ ((row & 7) << 1)) << 4); }
__device__ __forceinline__ void ma_item(const Ptrs& P, int item, LAS unsigned char* lds, const int wv, bool do_store = true) {
    const int tid = tid_of(wv), lane = tid & 63, w = __builtin_amdgcn_readfirstlane(tid >> 6), r32 = lane & 31, hi = lane >> 5, li = lane & 15, g = lane >> 4;
    const int qcx = item & 7, h = (item >> 3) & 3, b = item >> 5;
    const bf16_t* MK = (const bf16_t*)(P.ws + WS_MK) + (size_t)b * MEML * 512 + h * 128;
    const bf16_t* MV = (const bf16_t*)(P.ws + WS_MV) + (size_t)b * MEML * 512 + h * 128;
    bf16_t* MQ = (bf16_t*)(P.ws + WS_NMQ) + 512 + h * 128;
    bf16x8 qfs[2][8];
#pragma unroll
    for (int si = 0; si < 2; ++si) { const size_t q0 = (size_t)b * SEQ + qcx * 512 + (w * 2 + si) * 32;
#pragma unroll
        for (int s = 0; s < 8; ++s) qfs[si][s] = *(const bf16x8*)(MQ + (q0 + r32) * 1024 + 16 * s + 8 * hi); }
#pragma unroll
    for (int i = 0; i < 8; ++i) { const int ch = tid + i * 512; const int key = ch >> 4, c = ch & 15;
        const u32x4 kv = *(const u32x4*)(MK + (size_t)key * 512 + c * 8), vv = *(const u32x4*)(MV + (size_t)key * 512 + c * 8);
        *(LAS u32x4*)(lds + MA_K + swm(key, c)) = kv; *(LAS u32x4*)(lds + MA_V + swmv(key, c)) = vv; }
    __syncthreads();
    const int kx = r32 & 15; const int kro = r32 * 256;
    const int vrow = 4 * hi + (li >> 2); const int vx = (vrow & 7) << 1; const int vc0 = 2 * (g & 1) + ((li & 3) >> 1); const int vro = vrow * 256 + (li & 1) * 8;
    int voff[4];
#pragma unroll
    for (int d = 0; d < 4; ++d) voff[d] = vro + (((4 * d + vc0) ^ vx) << 4);
#pragma unroll
    for (int si = 0; si < 2; ++si) {
        const size_t q0 = (size_t)b * SEQ + qcx * 512 + (w * 2 + si) * 32;
        bf16x8 qf[8];
#pragma unroll
        for (int s = 0; s < 8; ++s) qf[s] = qfs[si][s];
        f32x16 O[4];
#pragma unroll
        for (int d = 0; d < 4; ++d)
#pragma unroll
            for (int e = 0; e < 16; ++e) O[d][e] = 0.f;
        float rsum = 0.f;
#pragma unroll 1
        for (int kt = 0; kt < 8; ++kt) {
            const LAS unsigned char* kp = lds + MA_K + kt * 8192 + kro; const LAS unsigned char* vp = lds + MA_V + kt * 8192;
            bf16x8 ka[8]; s16x4 va[2][4][2];
#pragma unroll
            for (int s = 0; s < 8; ++s) ka[s] = *(const LAS bf16x8*)(kp + (((2 * s + hi) ^ kx) << 4));
#pragma unroll
            for (int s = 0; s < 2; ++s)
#pragma unroll
                for (int d = 0; d < 4; ++d) { va[s][d][0] = tr_read(vp + voff[d] + s * 4096); va[s][d][1] = tr_read(vp + voff[d] + s * 4096 + 2048); }
            f32x16 sc0, sc1;
#pragma unroll
            for (int e = 0; e < 16; ++e) { sc0[e] = 0.f; sc1[e] = 0.f; }
#pragma unroll
            for (int s = 0; s < 4; ++s) { sc0 = mfma32(ka[2 * s], qf[2 * s], sc0); sc1 = mfma32(ka[2 * s + 1], qf[2 * s + 1], sc1); }
            unsigned pw[8];
#pragma unroll
            for (int e = 0; e < 8; ++e) { const float p0 = fexp2(sc0[2 * e] + sc1[2 * e]), p1 = fexp2(sc0[2 * e + 1] + sc1[2 * e + 1]); rsum += p0 + p1; pw[e] = cvtpk(p0, p1); }
#pragma unroll
            for (int s = 0; s < 2; ++s) { const u32x4 bw = {pw[4 * s], pw[4 * s + 1], pw[4 * s + 2], pw[4 * s + 3]}; const bf16x8 bfr = __builtin_bit_cast(bf16x8, bw);
#pragma unroll
                for (int d = 0; d < 4; ++d) O[d] = mfma32(cat44(va[s][d][0], va[s][d][1]), bfr, O[d]); }
        }
        rsum += bperm(rsum, lane ^ 32);
        const float inv = 1.0f / rsum;
#pragma unroll
        for (int d = 0; d < 4; ++d)
#pragma unroll
            for (int g4 = 0; g4 < 4; g4 += 2) {
                u32x2 a, b; a.x = cvtpk(O[d][4 * g4] * inv, O[d][4 * g4 + 1] * inv); a.y = cvtpk(O[d][4 * g4 + 2] * inv, O[d][4 * g4 + 3] * inv);
                b.x = cvtpk(O[d][4 * g4 + 4] * inv, O[d][4 * g4 + 5] * inv); b.y = cvtpk(O[d][4 * g4 + 6] * inv, O[d][4 * g4 + 7] * inv);
                auto rx = __builtin_amdgcn_permlane32_swap(a.x, b.x, false, false); auto ry = __builtin_amdgcn_permlane32_swap(a.y, b.y, false, false);
                const u32x4 ow = {rx[0], ry[0], rx[1], ry[1]};
                if (do_store) *(u32x4*)(MQ + (q0 + r32) * 1024 + 32 * d + 8 * g4 + 8 * hi) = ow; else asm volatile("" :: "v"(ow)); }
    }
    __syncthreads();
}

#define XB_TMO      128
#define XB_XCNT(j)  (256  + 64 * (j))
#define XB_XSUB(j)  (1280 + 64 * (j))
#define XB_XGEN(j)  (2304 + 64 * (j))
#define XB_TOP      3328
#define XB_TOPGEN   3392
#define XCD_BAR_WORDS 3456
#define XB_SPIN_CAP (1u << 18)

__device__ __forceinline__ unsigned xb_ld(unsigned* p)              { return __hip_atomic_load(p, __ATOMIC_RELAXED, __HIP_MEMORY_SCOPE_AGENT); }
__device__ __forceinline__ unsigned xb_add(unsigned* p, unsigned v) { return __hip_atomic_fetch_add(p, v, __ATOMIC_RELAXED, __HIP_MEMORY_SCOPE_AGENT); }
__device__ __forceinline__ unsigned xb_xcc_id() { return (unsigned)__builtin_amdgcn_s_getreg((3 << 11) | 20) & 0xFu; }
#define XB_SPIN(cond, bar) do { unsigned _sp = 0; while (cond) { __builtin_amdgcn_s_sleep(1); \
    if ((++_sp & 255u) == 0u) { if (xb_ld(&(bar)[XB_TMO])) break; if (_sp > XB_SPIN_CAP) { atomicAdd(&(bar)[XB_TMO], 1u); break; } } } } while (0)

struct XcdBarrier {
    unsigned* bar; unsigned x;
    volatile LAS unsigned* st;
};

__device__ __forceinline__ XcdBarrier xcd_barrier_post(unsigned* bar, volatile LAS unsigned* st, const int wv) {
    XcdBarrier b; b.bar = bar; b.x = xb_xcc_id(); b.st = st;
    if (tid_of(wv) == 0) (void)xb_add(&bar[XB_XCNT(b.x)], 1u);
    return b;
}
__device__ __forceinline__ void xcd_barrier_complete(unsigned* bar, unsigned x, unsigned& nloc, unsigned& nx) {
    const unsigned G = gridDim.x * gridDim.y * gridDim.z;
    unsigned sum, cnt, mine, sp = 0u;
    for (;;) {
        sum = 0u; cnt = 0u; mine = 0u;
#pragma unroll
        for (unsigned j = 0; j < 16; ++j) { const unsigned c = xb_ld(&bar[XB_XCNT(j)]); sum += c; cnt += (c > 0u) ? 1u : 0u; mine = (j == x) ? c : mine; }
        if (sum == G) break;
        __builtin_amdgcn_s_sleep(1);
        if ((++sp & 255u) == 0u) { if (xb_ld(&bar[XB_TMO])) break; if (sp > XB_SPIN_CAP) { atomicAdd(&bar[XB_TMO], 1u); break; } }
    }
    nloc = mine > 0u ? mine : 1u; nx = cnt > 0u ? cnt : 1u;
}

__device__ __forceinline__ void xcd_barrier(const XcdBarrier& b, const int wv) {
    asm volatile("s_waitcnt vmcnt(0)" ::: "memory");
    __syncthreads();
    if (tid_of(wv) == 0) {
        unsigned* bar = b.bar;
        __builtin_amdgcn_s_waitcnt(0);
        unsigned nloc = b.st[0], nx = b.st[1];
        if (nloc == 0u) { xcd_barrier_complete(bar, b.x, nloc, nx); b.st[0] = nloc; b.st[1] = nx; }
        const unsigned old = xb_add(&bar[XB_XSUB(b.x)], 1u);
        const unsigned gen = old / nloc;
        if (old + 1u == (gen + 1u) * nloc) {
            __builtin_amdgcn_fence(__ATOMIC_RELEASE, "agent");
            asm volatile("s_waitcnt vmcnt(0)" ::: "memory");
            const unsigned og = xb_add(&bar[XB_TOP], 1u);
            const unsigned tg = og / nx;
            if (og + 1u == (tg + 1u) * nx) xb_add(&bar[XB_TOPGEN], 1u);
            else XB_SPIN(xb_ld(&bar[XB_TOPGEN]) == tg, bar);
            __builtin_amdgcn_fence(__ATOMIC_ACQUIRE, "agent");
            xb_add(&bar[XB_XGEN(b.x)], 1u);
            asm volatile("s_waitcnt vmcnt(0)" ::: "memory");
        } else {
            XB_SPIN(xb_ld(&bar[XB_XGEN(b.x)]) == gen, bar);
            __builtin_amdgcn_fence(__ATOMIC_ACQUIRE, "agent");
            asm volatile("s_waitcnt vmcnt(0)" ::: "memory");
        }
    }
    __syncthreads();
}


constexpr int PH_PER_LAYER = 7, N_PHASES = DEPTH * PH_PER_LAYER;
__global__ void __launch_bounds__(NTHR, 2) fwd_kernel(Args args) {
    extern __shared__ __attribute__((aligned(16))) unsigned char lds_raw[];
    LAS unsigned char* lds = (LAS unsigned char*)lds_raw;
    Ptrs P;
    P.x = args.in[0]; P.mem = args.in[1]; P.norm_g = args.in[2]; P.w_in = args.in[3]; P.w2f = args.in[4]; P.bf = args.in[5]; P.w2b = args.in[6]; P.bb = args.in[7];
    P.gla_out_g = args.in[8]; P.p_a = args.in[9]; P.na_q_g = args.in[10]; P.na_k_g = args.in[11]; P.rpb = args.in[12]; P.p_b = args.in[13]; P.mem_norm_g = args.in[14];
    P.w_mem = args.in[15]; P.mem_q_g = args.in[16]; P.mem_k_g = args.in[17]; P.p_c = args.in[18]; P.w_out = args.in[19]; P.out = args.out; P.ws = args.ws;
    const int G = gridDim.x, bx0 = blockIdx.x;
    const int vcu = (G % 8 == 0) ? (bx0 % 8) * (G / 8) + bx0 / 8 : bx0;
    unsigned char* ws = args.ws;
    volatile LAS unsigned* ctlw = (volatile LAS unsigned*)(lds + LDS_CTLW);
    const int wv = __builtin_amdgcn_readfirstlane((int)(threadIdx.x >> 6));
    if (threadIdx.x < 16) ctlw[threadIdx.x] = 0u;
    __syncthreads();
    XcdBarrier bar; bar.bar = (unsigned*)(ws + WS_CTL); bar.x = 0; bar.st = nullptr;
    if (args.ph_hi - args.ph_lo > 1) bar = xcd_barrier_post((unsigned*)(ws + WS_CTL), ctlw, wv);
    for (int ph = args.ph_lo; ph < args.ph_hi; ++ph) {
        int l = ph / PH_PER_LAYER, p = ph % PH_PER_LAYER; asm volatile("" : "+s"(l), "+s"(p));
        const float* xin = l == 0 ? P.x : P.out;
        int bx = bx0; asm volatile("" : "+s"(bx));
        { GAS unsigned char* w_ = (GAS unsigned char*)args.ws; asm volatile("" : "+s"(w_)); ws = (unsigned char*)w_; P.ws = ws; }
        for (int rep = 0; rep < ((PROBE_REP >= 0 && PROBE_REP < 10 && PROBE_REP == p && l == 0) ? 2 : 1); ++rep) {
#ifndef ONLY_PHASE
#define ONLY_PHASE -1
#endif
#define PHSEL(k) (p == (k) && (ONLY_PHASE < 0 || ONLY_PHASE == (k)))
        if (PHSEL(0)) {
            p0_phase(P, l, lds, vcu, G, xin, wv);
        } else if (PHSEL(1)) {
            SchedP1 S{(const char*)(ws + WS_H), (const char*)(ws + WS_WIN), (const char*)(ws + WS_HMEM), (const char*)(ws + WS_WMEM), G, bx};
            if ((PROBE_REP == 11 || PROBE_REP == 12) && l == 0) { EpiP1 E0{ws, P.na_q_g + l * 64, P.na_k_g + l * 64, P.mem_q_g + l * 128, P.mem_k_g + l * 128, PROBE_REP - 10}; pg8::gemm_phase<EpiP1, SchedP1>(lds, 1024, 1024, S, E0, wv); }
            EpiP1 E{ws, P.na_q_g + l * 64, P.na_k_g + l * 64, P.mem_q_g + l * 128, P.mem_k_g + l * 128, 0};
            pg8::gemm_phase<EpiP1, SchedP1>(lds, 1024, 1024, S, E, wv);
        } else if (PHSEL(2)) {
            for (int st = 0; st < 2; ++st) {
                if ((st ^ ((0x22 >> (bx & 7)) & 1)) == 0) {
                    for (int it = bx; it < NB * 8 * 4; it += G) na_item(P, l, it, lds, wv);
                    for (int it = bx; it < NB * 4 * 8; it += G) ma_item(P, it, lds, wv);
                } else glaprep_phase(P, l, lds, bx, G, wv, 0);
                __syncthreads();
            }
        } else if (PHSEL(3)) {
            { int nrep = (PROBE_REP == 40 && l == 0) ? 2 : 1; asm volatile("" : "+s"(nrep));
              for (int rr = 0; rr < nrep; ++rr) for (int it = bx; it < 256; it += G) gla_item(P, l, it, lds, wv); }
        } else if (PHSEL(4)) {
            SchedTiles S{(const char*)(ws + WS_H), (const char*)(ws + WS_WGATE), 128, 8, 1024, 1024, 16, G, bx};
            if ((PROBE_REP == 13 || PROBE_REP == 17) && l == 0) { EpiGate E0{(bf16_t*)(ws + WS_OF), (bf16_t*)(ws + WS_OBW), (bf16_t*)(ws + WS_NMQ), P.gla_out_g + l * 256, PROBE_REP == 13 ? 1 : 2}; pg8::gemm_phase<EpiGate, SchedTiles>(lds, 1024, 1024, S, E0, wv); }
            EpiGate E{(bf16_t*)(ws + WS_OF), (bf16_t*)(ws + WS_OBW), (bf16_t*)(ws + WS_NMQ), P.gla_out_g + l * 256, 0};
            pg8::gemm_phase<EpiGate, SchedTiles>(lds, 1024, 1024, S, E, wv);
        } else if (PHSEL(5)) {
            SchedP3 S{(const char*)(ws + WS_H), (const char*)(ws + WS_OF), (const char*)(ws + WS_NMQ), (const char*)(ws + WS_WP3), G, bx};
            EpiP3 E{(bf16_t*)(ws + WS_Y)};
            pg8::gemm_phase<EpiP3, SchedP3>(lds, 1024, KP3, S, E, wv);
        } else if (PHSEL(6)) {
            SchedTiles S{(const char*)(ws + WS_Y), (const char*)(ws + WS_WOUT), 128, 4, 1024, 1024, 16, G, bx};
            EpiP4 E{xin, P.out};
            pg8::gemm_phase<EpiP4, SchedTiles>(lds, 1024, 1024, S, E, wv);
        }
        }
        if (ph + 1 < args.ph_hi) { xcd_barrier(bar, wv); }
    }
}

extern "C" void kernel_launch(void* const* d_in, const int* in_sizes, int n_in, void* d_out, int out_size, void* d_ws, size_t ws_size, hipStream_t stream) {
    static int grid = 0;
    if (grid == 0) {
        if (n_in != 20 || out_size != T * DM || ws_size < WS_END) { fprintf(stderr, "kernel_launch: unexpected problem (n_in %d out %d ws %zu)\n", n_in, out_size, ws_size); grid = -1; return; }
        int dev = 0, cus = 0, per_cu = 0;
        hipGetDevice(&dev); hipDeviceGetAttribute(&cus, hipDeviceAttributeMultiprocessorCount, dev);
        hipFuncSetAttribute((const void*)fwd_kernel, hipFuncAttributeMaxDynamicSharedMemorySize, LDS_BYTES);
        hipOccupancyMaxActiveBlocksPerMultiprocessor(&per_cu, (const void*)fwd_kernel, NTHR, LDS_BYTES);
        (void)hipGetLastError();
        if (per_cu < 1) { fprintf(stderr, "kernel_launch: occupancy query says %d blocks/CU\n", per_cu); per_cu = 1; }
        grid = cus;
    }
    if (grid < 0) return;
    Args a{};
    for (int i = 0; i < 20; ++i) a.in[i] = (const float*)d_in[i];
    a.out = (float*)d_out; a.ws = (unsigned char*)d_ws;
    if (MK_N_LAUNCHES == 1) {
        a.ph_lo = 0; a.ph_hi = N_PHASES;
        if (hipMemsetAsync((char*)d_ws + WS_CTL, 0, 65536, stream) != hipSuccess) { fprintf(stderr, "kernel_launch: memset of the barrier words failed\n"); return; }
        hipLaunchKernelGGL(fwd_kernel, dim3(grid), dim3(NTHR), LDS_BYTES, stream, a);
        const hipError_t e = hipPeekAtLastError();
        if (e != hipSuccess) fprintf(stderr, "launch failed: %s (grid %d)\n", hipGetErrorString(e), grid);
    } else {
        for (int ph = 0; ph < N_PHASES; ++ph) { a.ph_lo = ph; a.ph_hi = ph + 1; hipLaunchKernelGGL(fwd_kernel, dim3(grid), dim3(NTHR), LDS_BYTES, stream, a); }
    }
}
```

```cpp
#include <hip/hip_runtime.h>
#include <cstdio>
#include <cstdint>

#ifndef MK_N_LAUNCHES
#define MK_N_LAUNCHES 1
#endif

#ifndef PROBE_REP
#define PROBE_REP -1
#endif
#define LAS __attribute__((address_space(3)))
#define GAS __attribute__((address_space(1)))
typedef unsigned short bf16_t;
typedef short bf16x8 __attribute__((ext_vector_type(8)));
typedef short s16x4 __attribute__((ext_vector_type(4)));
typedef float f32x4 __attribute__((ext_vector_type(4)));
typedef float f32x16 __attribute__((ext_vector_type(16)));
typedef float f32x2 __attribute__((ext_vector_type(2)));
typedef unsigned u32x4 __attribute__((ext_vector_type(4)));
typedef unsigned u32x2 __attribute__((ext_vector_type(2)));
typedef __bf16 bf16x2_t __attribute__((ext_vector_type(2)));

constexpr int DM = 1024, NB = 8, SEQ = 4096, T = NB * SEQ, DEPTH = 2, MEML = 256, TMEM = NB * MEML;
constexpr int IN_COLS = 9248;
constexpr float EPS = 1e-6f, LOG2E = 1.4426950408889634f;
constexpr int NWAVES = 8, NTHR = 512;
constexpr int N1 = 4352;
constexpr int KP3 = 5120;

constexpr size_t MiB = 1u << 20;
constexpr size_t WS_CTL = 0;
constexpr size_t WS_WIN = 1 * MiB;
constexpr size_t WS_WGATE = WS_WIN + (size_t)N1 * 1024 * 2;
constexpr size_t WS_WP3 = WS_WGATE + (size_t)2048 * 1024 * 2;
constexpr size_t WS_WOUT = WS_WP3 + (size_t)1024 * KP3 * 2;
constexpr size_t WS_WMEM = WS_WOUT + (size_t)1024 * 1024 * 2;
constexpr size_t WS_HMEM = WS_WMEM + (size_t)1024 * 1024 * 2;
constexpr size_t WS_MK = WS_HMEM + (size_t)TMEM * 1024 * 2;
constexpr size_t WS_MV = WS_MK + (size_t)TMEM * 512 * 2;
constexpr size_t WS_GLR = WS_MV + (size_t)TMEM * 512 * 2;
constexpr size_t WS_H = 40 * MiB;
constexpr size_t WS_GQ = WS_H + 64 * MiB;
constexpr size_t WS_GK = WS_GQ + 32 * MiB;
constexpr size_t WS_GV = WS_GK + 32 * MiB;
constexpr size_t WS_NMQ = WS_GV + 64 * MiB;
constexpr size_t WS_NK = WS_NMQ + 64 * MiB;
constexpr size_t WS_NV = WS_NK + 32 * MiB;
constexpr size_t WS_OF = WS_NV + 32 * MiB;
constexpr size_t WS_OB = WS_OF + 64 * MiB;
constexpr size_t WS_DEC = WS_OB + 64 * MiB;
constexpr size_t WS_END = WS_DEC + 2 * MiB;
constexpr size_t WS_QEB = WS_OB, WS_KEB = WS_OB + 32 * MiB;
constexpr size_t WS_OBW = WS_NK;
constexpr size_t WS_Y = WS_GQ;
constexpr size_t WS_SG = WS_GV;
static_assert(WS_GLR + (size_t)T * 32 * 4 <= WS_H, "ws map");
static_assert(WS_END <= 512 * MiB, "ws map");

constexpr int LDS_EPI = 131072;
constexpr int LDS_CTLW = 159744;
constexpr int LDS_BYTES = 160768;

__device__ __forceinline__ unsigned cvtpk(float lo, float hi) { f32x2 v = {lo, hi}; bf16x2_t b = __builtin_convertvector(v, bf16x2_t); return __builtin_bit_cast(unsigned, b); }
__device__ __forceinline__ float bf_lo(unsigned u) { return __builtin_bit_cast(float, u << 16); }
__device__ __forceinline__ float bf_hi(unsigned u) { return __builtin_bit_cast(float, u & 0xffff0000u); }
__device__ __forceinline__ float fexp2(float x) { return __builtin_amdgcn_exp2f(x); }
__device__ __forceinline__ float frcp(float x) { return __builtin_amdgcn_rcpf(x); }
__device__ __forceinline__ float silu_f(float a) { return a * frcp(1.f + fexp2(-a * LOG2E)); }
__device__ __forceinline__ float sigmoid_f(float a) { return frcp(1.f + fexp2(-a * LOG2E)); }
__device__ __forceinline__ unsigned opaque(unsigned v) { asm volatile("" : "+v"(v)); return v; }
__device__ __forceinline__ float frsq(float x) { return __builtin_amdgcn_rsqf(x); }
__device__ __forceinline__ int tid_of(int wv) { unsigned l_; asm volatile("v_mbcnt_lo_u32_b32 %0, -1, 0\n\tv_mbcnt_hi_u32_b32 %0, -1, %0" : "=v"(l_)); return wv * 64 + (int)l_; }
__device__ __forceinline__ float bperm(float v, int src_lane) { return __builtin_bit_cast(float, __builtin_amdgcn_ds_bpermute(src_lane << 2, __builtin_bit_cast(int, v))); }
__device__ __forceinline__ float wave_sum(float v, int lane) {
#pragma unroll
    for (int o = 1; o < 64; o <<= 1) v += bperm(v, lane ^ o);
    return v;
}
__device__ __forceinline__ s16x4 tr_read(const LAS unsigned char* p) { return __builtin_bit_cast(s16x4, __builtin_amdgcn_ds_read_tr16_b64_v4i16((LAS s16x4*)p)); }
__device__ __forceinline__ bf16x8 cat44(s16x4 a, s16x4 b) { return (bf16x8){a[0], a[1], a[2], a[3], b[0], b[1], b[2], b[3]}; }
__device__ __forceinline__ f32x4 mfma16(bf16x8 a, bf16x8 b, f32x4 c) { return __builtin_amdgcn_mfma_f32_16x16x32_bf16(a, b, c, 0, 0, 0); }
__device__ __forceinline__ f32x16 mfma32(bf16x8 a, bf16x8 b, f32x16 c) { return __builtin_amdgcn_mfma_f32_32x32x16_bf16(a, b, c, 0, 0, 0); }

namespace pg8 {
constexpr int BM = 256, BK = 64, HALF = 128, HTB = HALF * BK * 2, STAGE_BYTES = 8 * HTB, NXCD = 8, WGM = 8;
__host__ __device__ __forceinline__ int lds_byte(int r, int c) { const int st = (r >> 4) * 2 + (c >> 5), rr = r & 15, cc = c & 31, ob = rr * 64 + cc * 2; return st * 1024 + (ob ^ (((ob >> 9) & 1) << 5)); }
__host__ __device__ __forceinline__ void stage_rc(int b, int& R, int& C) { const int st = b / 1024, sb = b % 1024, swz = sb ^ (((sb >> 9) & 1) << 5); R = (st >> 1) * 16 + swz / 64; C = (st & 1) * 32 + (swz % 64) / 2; }
__host__ __device__ __forceinline__ int perm32(int rho) { const int n = rho >> 4, i = rho & 15; return 8 * (i >> 2) + 4 * n + (i & 3); }

struct Unit { const char* A; const char* B; int nt; int pm, pn, kind; };
__device__ __forceinline__ void tile_of(int L, int nM, int nN, int& pm, int& pn) {
    const int nwg = nM * nN; int wgid = L; { const int q = nwg / NXCD, r = nwg % NXCD, xcd = wgid % NXCD, off = wgid / NXCD; wgid = (xcd < r ? xcd * (q + 1) : r * (q + 1) + (xcd - r) * q) + off; }
    const int nig = WGM * nN, gid = wgid / nig, fm = gid * WGM, gsz = (nM - fm) < WGM ? (nM - fm) : WGM;
    pm = fm + ((wgid % nig) % gsz); pn = (wgid % nig) / gsz;
}

template <class Epi, class Sched>
__device__ __forceinline__ void gemm_phase(LAS unsigned char* lds, const int lda, const int ldb, const Sched& S, const Epi& E, const int wv) {
    const int tid = tid_of(wv), wid = __builtin_amdgcn_readfirstlane(tid >> 6), lane = tid & 63, wr = wid >> 2, wc = wid & 3, fr = lane & 15, fq = lane >> 4;
    unsigned voffA[2], voffB[2];
#pragma unroll
    for (int i = 0; i < 2; ++i) { int R, C; stage_rc(tid * 16 + i * 8192, R, C); const int Rb = (R & ~31) + perm32(R & 31);
        voffA[i] = (unsigned)(R * lda + C) * 2u; voffB[i] = (unsigned)(Rb * ldb + C) * 2u; }
    const size_t kstep = (size_t)(BK * 2);
    const size_t hstepA = (size_t)HALF * lda * 2, hstepB = (size_t)HALF * ldb * 2;
    const unsigned ldsw = (unsigned)wid * 1024u;
    const int aoff = lds_byte(wr * 64 + fr, fq * 8), boff = lds_byte(wc * 32 + fr, fq * 8);
#define PG8_SA(b, h) (((b) * 2 + (h)) * HTB)
#define PG8_SB(b, h) ((4 + (b) * 2 + (h)) * HTB)
#define PG8_STAGE(bufoff, gbase, voff) do { _Pragma("unroll") for (int _i = 0; _i < 2; ++_i) \
        __builtin_amdgcn_global_load_lds((const unsigned*)((const char*)(gbase) + (voff)[_i]), (LAS unsigned*)(lds + (bufoff) + ldsw + _i * 8192), 16, 0, 0); } while (0)
#define PG8_LDA(dst, b, h) do { _Pragma("unroll") for (int m = 0; m < 4; ++m) _Pragma("unroll") for (int k = 0; k < 2; ++k) dst[m][k] = *(const LAS bf16x8*)(lds + PG8_SA(b, h) + aoff + m * 2048 + k * 1024); } while (0)
#define PG8_LDB(dst, b, h) do { _Pragma("unroll") for (int n = 0; n < 2; ++n) _Pragma("unroll") for (int k = 0; k < 2; ++k) dst[n][k] = *(const LAS bf16x8*)(lds + PG8_SB(b, h) + boff + n * 2048 + k * 1024); } while (0)
#define PG8_MMA(ai, bj, At, Bt) do { __builtin_amdgcn_s_setprio(1); _Pragma("unroll") for (int m = 0; m < 4; ++m) _Pragma("unroll") for (int n = 0; n < 2; ++n) _Pragma("unroll") for (int k = 0; k < 2; ++k) \
        acc[ai][bj][m][n] = __builtin_amdgcn_mfma_f32_16x16x32_bf16(Bt[n][k], At[m][k], acc[ai][bj][m][n], 0, 0, 0); __builtin_amdgcn_s_setprio(0); } while (0)
#define PG8_WAIT_V(n) asm volatile("s_waitcnt vmcnt(" #n ")" ::: "memory")
#define PG8_WAIT_L(n) asm volatile("s_waitcnt lgkmcnt(" #n ")" ::: "memory")
#define PG8_BAR __builtin_amdgcn_s_barrier()
#define PG8_SCHED __builtin_amdgcn_sched_barrier(0)
    Unit cur, nxt; int ui = 0;
    typename Epi::State est;
    if (!S.next(0, cur)) return;
    const char* cA = cur.A; const char* cB = cur.B;
    PG8_STAGE(PG8_SB(0, 0), cB, voffB); PG8_STAGE(PG8_SB(0, 1), cB + hstepB, voffB); PG8_STAGE(PG8_SA(0, 0), cA, voffA); PG8_STAGE(PG8_SA(0, 1), cA + hstepA, voffA);
    if (wr == 1) PG8_BAR;
    PG8_WAIT_V(2); PG8_BAR;
    PG8_STAGE(PG8_SB(1, 0), cB + kstep, voffB); PG8_STAGE(PG8_SA(1, 0), cA + kstep, voffA); PG8_STAGE(PG8_SB(1, 1), cB + hstepB + kstep, voffB);
    PG8_WAIT_V(0); PG8_BAR;
    asm volatile("" ::: "memory");
    f32x4 acc[2][2][4][2];
#pragma unroll
    for (int a = 0; a < 2; ++a)
#pragma unroll
        for (int b = 0; b < 2; ++b)
#pragma unroll
            for (int m = 0; m < 4; ++m)
#pragma unroll
                for (int n = 0; n < 2; ++n) acc[a][b][m][n] = (f32x4){0.f, 0.f, 0.f, 0.f};
    bf16x8 At[4][2], B0[2][2], B1[2][2];
    for (;;) {
        const bool has_next = S.next(ui + 1, nxt);
        const char* nA = has_next ? nxt.A : cA; const char* nB = has_next ? nxt.B : cB;
        const int nt = cur.nt;
        for (int t = 0; t < nt; t += 2) {
            const bool last = (t == nt - 2);
            const char* a1 = cA + (size_t)(t + 1) * kstep;
            const char* a2 = last ? nA : cA + (size_t)(t + 2) * kstep; const char* b2 = last ? nB : cB + (size_t)(t + 2) * kstep;
            const char* a3 = a2 + kstep; const char* b3 = b2 + kstep;
            int tz = t; asm volatile("" : "+s"(tz));
            PG8_LDB(B0, 0, 0); PG8_LDB(B1, 0, 1); PG8_SCHED; PG8_LDA(At, 0, 0); PG8_STAGE(PG8_SA(1, 1), a1 + hstepA, voffA);
            if (tz != 0) PG8_WAIT_V(8);
            PG8_WAIT_L(0); PG8_BAR; PG8_MMA(0, 0, At, B0); PG8_MMA(0, 1, At, B1); PG8_BAR; PG8_SCHED;
            PG8_LDA(At, 0, 1); PG8_STAGE(PG8_SB(0, 0), b2, voffB); PG8_STAGE(PG8_SB(0, 1), b2 + hstepB, voffB); PG8_STAGE(PG8_SA(0, 0), a2, voffA);
            if (tz != 0) PG8_WAIT_V(8);
            PG8_WAIT_L(0); PG8_BAR; PG8_MMA(1, 0, At, B0); PG8_MMA(1, 1, At, B1); PG8_BAR; PG8_SCHED;
            PG8_LDB(B0, 1, 0); PG8_LDB(B1, 1, 1); PG8_SCHED; PG8_LDA(At, 1, 0); PG8_STAGE(PG8_SA(0, 1), a2 + hstepA, voffA);
            PG8_WAIT_V(8); PG8_WAIT_L(0); PG8_BAR; PG8_MMA(0, 0, At, B0); PG8_MMA(0, 1, At, B1); PG8_BAR; PG8_SCHED;
            PG8_LDA(At, 1, 1); PG8_STAGE(PG8_SB(1, 0), b3, voffB); PG8_STAGE(PG8_SB(1, 1), b3 + hstepB, voffB); PG8_STAGE(PG8_SA(1, 0), a3, voffA);
            PG8_WAIT_V(8); PG8_WAIT_L(0); PG8_BAR; PG8_MMA(1, 0, At, B0); PG8_MMA(1, 1, At, B1); PG8_BAR; PG8_SCHED;
        }
        PG8_WAIT_V(0);
        if (wr == 0) PG8_BAR;
        E(acc, cur, wr, wc, fr, fq, lds + LDS_EPI, est);
        if (!has_next) break;
#pragma unroll
        for (int a = 0; a < 2; ++a)
#pragma unroll
            for (int b = 0; b < 2; ++b)
#pragma unroll
                for (int m = 0; m < 4; ++m)
#pragma unroll
                    for (int n = 0; n < 2; ++n) acc[a][b][m][n] = (f32x4){0.f, 0.f, 0.f, 0.f};
        cur = nxt; cA = nA; cB = nB; ++ui;
        if (wr == 1) PG8_BAR;
    }
    PG8_WAIT_V(0);
    PG8_BAR;
#undef PG8_SA
#undef PG8_SB
#undef PG8_STAGE
#undef PG8_LDA
#undef PG8_LDB
#undef PG8_MMA
}
#define GOFF(g) ((size_t)(((g) >> 2) * 128 + ((g) & 3) * 16) * 2048)
#define EPI_BAR() do { asm volatile("s_waitcnt lgkmcnt(0)" ::: "memory"); __builtin_amdgcn_s_barrier(); asm volatile("" ::: "memory"); } while (0)

__device__ __forceinline__ void ssq_put(float s, int rowt, int bj, int wc, int fq, LAS float* P) {
    const int ln_ = (rowt & 15) | (fq << 4);
    s += bperm(s, ln_ ^ 16); s += bperm(s, ln_ ^ 32);
    if (fq == 0) P[rowt * 8 + bj * 4 + wc] = s;
}
}
using pg8::Unit;

struct Args { const float* in[20]; float* out; unsigned char* ws; int ph_lo, ph_hi; };

struct Ptrs {
    const float *x, *mem, *norm_g, *w_in, *w2f, *bf, *w2b, *bb, *gla_out_g, *p_a, *na_q_g, *na_k_g, *rpb, *p_b, *mem_norm_g, *w_mem, *mem_q_g, *mem_k_g, *p_c, *w_out;
    float* out; unsigned char* ws;
};

__device__ __forceinline__ void p0_transpose_item(const float* W, int srcN, int c0, int ncols, bf16_t* WT, int row0, int ld, int koff, LAS float* scr, int item, int lane) {
    const int nblk = ncols / 32, kb = item / nblk, nb = item % nblk, k0 = 64 * kb, n0 = 32 * nb;
#pragma unroll 8
    for (int i = 0; i < 32; ++i) { const int kk = 2 * i + (lane >> 5); scr[kk * 33 + (lane & 31)] = W[(size_t)(k0 + kk) * srcN + c0 + n0 + (lane & 31)]; }
    asm volatile("s_waitcnt lgkmcnt(0)" ::: "memory");
    const int c = lane & 7;
#pragma unroll
    for (int j = 0; j < 4; ++j) { const int n = (lane >> 3) + 8 * j; const LAS float* s = scr + (8 * c) * 33 + n;
        u32x4 o; o.x = cvtpk(s[0 * 33], s[1 * 33]); o.y = cvtpk(s[2 * 33], s[3 * 33]); o.z = cvtpk(s[4 * 33], s[5 * 33]); o.w = cvtpk(s[6 * 33], s[7 * 33]);
        *(u32x4*)(WT + (size_t)(row0 + n0 + n) * ld + koff + k0 + 8 * c) = o; }
    asm volatile("s_waitcnt lgkmcnt(0)" ::: "memory");
}
__device__ __forceinline__ void rms_rows_to_bf16(const float* X, const float* g, bf16_t* O, int m0, int step, int nrows, int lane) {
    if (m0 >= nrows) return;
    const f32x4* gr = (const f32x4*)g + lane;
    f32x4 gg[4];
#pragma unroll
    for (int j = 0; j < 4; ++j) gg[j] = gr[64 * j];
    f32x4 vn[4];
    { const f32x4* xr = (const f32x4*)(X + (size_t)m0 * DM) + lane;
#pragma unroll
      for (int j = 0; j < 4; ++j) vn[j] = xr[64 * j]; }
    for (int m = m0; m < nrows; m += step) {
        f32x4 v[4];
#pragma unroll
        for (int j = 0; j < 4; ++j) v[j] = vn[j];
        if (m + step < nrows) { const f32x4* xr = (const f32x4*)(X + (size_t)(m + step) * DM) + lane;
#pragma unroll
            for (int j = 0; j < 4; ++j) vn[j] = xr[64 * j]; }
        float sq = 0.f;
#pragma unroll
        for (int j = 0; j < 4; ++j) sq += (v[j].x * v[j].x + v[j].y * v[j].y) + (v[j].z * v[j].z + v[j].w * v[j].w);
        const float rstd = 1.0f / sqrtf(wave_sum(sq, lane) * (1.f / DM) + EPS);
        u32x2* o8 = (u32x2*)(O + (size_t)m * DM) + lane;
#pragma unroll
        for (int j = 0; j < 4; ++j) { u32x2 w; w.x = cvtpk(v[j].x * rstd * gg[j].x, v[j].y * rstd * gg[j].y); w.y = cvtpk(v[j].z * rstd * gg[j].z, v[j].w * rstd * gg[j].w); o8[64 * j] = w; }
    }
}
struct Seg { int src, srcN, c0, ncols, K, dst, row0, ld, koff; };
__device__ __forceinline__ void p0_phase(const Ptrs& P, int l, LAS unsigned char* lds, int vcu, int G, const float* xin, const int wv) {
    const int tid = tid_of(wv), lane = tid & 63, wave = tid >> 6;
    LAS float* scr = (LAS float*)(lds + wave * 16384);
    const int gw = vcu * NWAVES + wave, NGW = G * NWAVES;
    constexpr int NSEG = 19;
    const Seg segs[NSEG] = {
        {0, IN_COLS, 0, 512, 1024, 0, 0, 1024, 0},
        {0, IN_COLS, 512, 512, 1024, 0, 512, 1024, 0},
        {0, IN_COLS, 1024, 1024, 1024, 0, 1024, 1024, 0},
        {0, IN_COLS, 3104, 512, 1024, 0, 2048, 1024, 0},
        {0, IN_COLS, 3616, 512, 1024, 0, 2560, 1024, 0},
        {0, IN_COLS, 4128, 512, 1024, 0, 3072, 1024, 0},
        {0, IN_COLS, 5152, 512, 1024, 0, 3584, 1024, 0},
        {0, IN_COLS, 3072, 32, 1024, 0, 4096, 1024, 0},
        {0, IN_COLS, 2048, 1024, 1024, 1, 0, 1024, 0},
        {0, IN_COLS, 4640, 512, 1024, 1, 1024, 1024, 0},
        {0, IN_COLS, 5664, 512, 1024, 1, 1536, 1024, 0},
        {0, IN_COLS, 6176, 1024, 1024, 2, 0, KP3, 0},
        {0, IN_COLS, 7200, 1024, 1024, 2, 0, KP3, 2048},
        {0, IN_COLS, 8224, 1024, 1024, 2, 0, KP3, 3584},
        {1, 1024, 0, 1024, 1024, 2, 0, KP3, 1024},
        {2, 1024, 0, 1024, 512, 2, 0, KP3, 3072},
        {3, 1024, 0, 1024, 512, 2, 0, KP3, 4608},
        {4, 1024, 0, 1024, 1024, 3, 0, 1024, 0},
        {5, 1024, 0, 1024, 1024, 4, 0, 1024, 0},
    };
    int total = 0;
#pragma unroll
    for (int s = 0; s < NSEG; ++s) total += (segs[s].K / 64) * (segs[s].ncols / 32);
    for (int it = gw; it < total; it += NGW) {
        int r = it;
#pragma unroll
        for (int s = 0; s < NSEG; ++s) {
            const int n = (segs[s].K / 64) * (segs[s].ncols / 32);
            if (r >= 0 && r < n) {
                const float* src = segs[s].src == 0 ? P.w_in + (size_t)l * 1024 * IN_COLS : segs[s].src == 1 ? P.p_a + (size_t)l * 1024 * 1024 : segs[s].src == 2 ? P.p_b + (size_t)l * 512 * 1024 :
                                   segs[s].src == 3 ? P.p_c + (size_t)l * 512 * 1024 : segs[s].src == 4 ? P.w_out + (size_t)l * 1024 * 1024 : P.w_mem + (size_t)l * 1024 * 1024;
                bf16_t* dst = (bf16_t*)(P.ws + (segs[s].dst == 0 ? WS_WIN : segs[s].dst == 1 ? WS_WGATE : segs[s].dst == 2 ? WS_WP3 : segs[s].dst == 3 ? WS_WOUT : WS_WMEM));
                p0_transpose_item(src, segs[s].srcN, segs[s].c0, segs[s].ncols, dst, segs[s].row0, segs[s].ld, segs[s].koff, scr, r, lane);
            }
            r -= n;
        }
    }
    { u32x4* z = (u32x4*)(P.ws + WS_WIN + (size_t)4128 * 1024 * 2); const int nz = 224 * 1024 * 2 / 16;
      const unsigned zz = opaque(0u);
      for (int i = vcu * NTHR + tid; i < nz; i += G * NTHR) z[i] = (u32x4){zz, zz, zz, zz}; }
    bf16_t* H = (bf16_t*)(P.ws + WS_H);
    rms_rows_to_bf16(xin, P.norm_g + l * DM, H, gw, NGW, T, lane);
    bf16_t* HM = (bf16_t*)(P.ws + WS_HMEM);
    rms_rows_to_bf16(P.mem, P.mem_norm_g + l * DM, HM, gw, NGW, TMEM, lane);
}

struct SchedP1 {
    const char* H; const char* W; const char* HM; const char* WM; int G, c;
    __device__ __forceinline__ bool next(int i, Unit& u) const {
        const int L = i * G + c; constexpr int NMAIN = 128 * 17;
        const bool mainu = L < NMAIN; const int r = L - NMAIN;
        if (!mainu && r >= 32) return false;
        int pm, pn; pg8::tile_of(mainu ? L : 0, 128, 17, pm, pn);
        if (!mainu) { pm = r >> 2; pn = r & 3; }
        const char* a = mainu ? H : HM; const char* b = mainu ? W : WM;
        Unit t; t.A = a + (size_t)pm * 256 * 1024 * 2; t.B = b + (size_t)pn * 256 * 1024 * 2; t.nt = 16; t.pm = pm; t.pn = pn; t.kind = mainu ? 0 : 1; u = t; return true;
    }
};
struct EpiNoState {};
struct EpiP1 {
    typedef EpiNoState State;
    unsigned char* ws; const float *na_q_g, *na_k_g, *mem_q_g, *mem_k_g; int skip;
    __device__ __forceinline__ void operator()(f32x4 (&acc)[2][2][4][2], const Unit& u, int wr, int wc, int fr_, int fq_, LAS unsigned char* le, State& est) const {
        if (skip == 1) { _Pragma("unroll") for (int a_ = 0; a_ < 2; ++a_) _Pragma("unroll") for (int m_ = 0; m_ < 4; ++m_) asm volatile("" :: "v"(acc[a_][0][m_][0]), "v"(acc[a_][0][m_][1]), "v"(acc[a_][1][m_][0]), "v"(acc[a_][1][m_][1])); return; }
        const int fr = (int)opaque((unsigned)fr_), fq = (int)opaque((unsigned)fq_);
        bf16_t* dst; int ldc, col0, mode = 0; float scale = 1.f; const float* gain = nullptr;
        const int pn = u.pn;
        bf16_t* const GQ = (bf16_t*)(ws + WS_GQ); bf16_t* const GK = (bf16_t*)(ws + WS_GK); bf16_t* const GV = (bf16_t*)(ws + WS_GV); bf16_t* const NMQ = (bf16_t*)(ws + WS_NMQ);
        bf16_t* const NK = (bf16_t*)(ws + WS_NK); bf16_t* const NV = (bf16_t*)(ws + WS_NV); bf16_t* const MK = (bf16_t*)(ws + WS_MK); bf16_t* const MV = (bf16_t*)(ws + WS_MV); float* const GLR = (float*)(ws + WS_GLR);
        if (u.kind == 0) {
            if (pn < 2) { dst = GQ; ldc = 512; col0 = pn * 256; scale = 0.08838834764831845f; }
            else if (pn < 4) { dst = GK; ldc = 512; col0 = (pn - 2) * 256; }
            else if (pn < 8) { dst = GV; ldc = 1024; col0 = (pn - 4) * 256; }
            else if (pn < 10) { dst = NMQ; ldc = 1024; col0 = (pn - 8) * 256; mode = 1; gain = na_q_g; scale = 0.125f * LOG2E; }
            else if (pn < 12) { dst = NK; ldc = 512; col0 = (pn - 10) * 256; mode = 1; gain = na_k_g; }
            else if (pn < 14) { dst = NV; ldc = 512; col0 = (pn - 12) * 256; }
            else if (pn < 16) { dst = NMQ; ldc = 1024; col0 = 512 + (pn - 14) * 256; mode = 2; gain = mem_q_g; scale = 0.08838834764831845f * LOG2E; }
            else { dst = nullptr; ldc = 0; col0 = 0; mode = 3; }
        } else {
            if (pn < 2) { dst = MK; ldc = 512; col0 = pn * 256; mode = 2; gain = mem_k_g; }
            else { dst = MV; ldc = 512; col0 = (pn - 2) * 256; }
        }
        if (mode == 3) {
            if (wc == 0) { const unsigned vo = opaque((unsigned)((wr * 64 + fr) * 64 + (fq >> 1) * 32 + (fq & 1) * 8) * 2u); char* ub = (char*)GLR + (size_t)u.pm * 256 * 64 * 2;
#pragma unroll
                for (int ai = 0; ai < 2; ++ai)
#pragma unroll
                    for (int m = 0; m < 4; ++m) { char* rp = ub + (ai * 128 + m * 16) * 64 * 2 + vo; const f32x4 a = acc[ai][0][m][0], b = acc[ai][0][m][1];
                        u32x4 hi; hi.x = cvtpk(a[0], a[1]); hi.y = cvtpk(a[2], a[3]); hi.z = cvtpk(b[0], b[1]); hi.w = cvtpk(b[2], b[3]);
                        u32x4 lo; lo.x = cvtpk(a[0] - bf_lo(hi.x), a[1] - bf_hi(hi.x)); lo.y = cvtpk(a[2] - bf_lo(hi.y), a[3] - bf_hi(hi.y)); lo.z = cvtpk(b[0] - bf_lo(hi.z), b[1] - bf_hi(hi.z)); lo.w = cvtpk(b[2] - bf_lo(hi.w), b[3] - bf_hi(hi.w));
                        *(u32x4*)rp = hi; *(u32x4*)(rp + 32) = lo; }
            }
            return;
        }
        f32x4 gv[2] = {(f32x4){1.f, 1.f, 1.f, 1.f}, (f32x4){1.f, 1.f, 1.f, 1.f}};
        LAS float* Pl = (LAS float*)le;
        if (mode != 0) {
#pragma unroll
            for (int ai = 0; ai < 2; ++ai)
#pragma unroll
                for (int m = 0; m < 4; ++m)
#pragma unroll
                    for (int bj = 0; bj < 2; ++bj) { const f32x4 a = acc[ai][bj][m][0], b = acc[ai][bj][m][1];
                        pg8::ssq_put((a.x * a.x + a.y * a.y) + (a.z * a.z + a.w * a.w) + (b.x * b.x + b.y * b.y) + (b.z * b.z + b.w * b.w), ai * 128 + wr * 64 + m * 16 + fr, bj, wc, fq, Pl); }
            EPI_BAR();
            const int gc = (mode == 1 ? (wc & 1) * 32 : wc * 32) + 8 * fq;
            gv[0] = *(const f32x4*)(gain + gc); gv[1] = *(const f32x4*)(gain + gc + 4);
        }
        const unsigned vo = opaque((unsigned)((wr * 64 + fr) * ldc + wc * 32 + 8 * fq) * 2u);
        char* ub = (char*)dst + ((size_t)u.pm * 256 * ldc + col0) * 2;
        const LAS float* qb = Pl + (wr * 64 + fr) * 8;
#pragma unroll
        for (int ai = 0; ai < 2; ++ai)
#pragma unroll
            for (int m = 0; m < 4; ++m) { asm volatile("" : "+v"(acc[ai][0][m][0]), "+v"(acc[ai][0][m][1]), "+v"(acc[ai][1][m][0]), "+v"(acc[ai][1][m][1]) :: "memory"); char* rowp = ub + (size_t)((ai * 128 + m * 16) * ldc) * 2 + vo;
#pragma unroll
                for (int bj = 0; bj < 2; ++bj) { float r = scale;
                    if (mode != 0) { const LAS float* q = qb + (ai * 128 + m * 16) * 8 + bj * 4;
                        float sq; if (mode == 1) sq = (q[wc & 2] + q[(wc & 2) + 1]) * (1.f / 64.f); else sq = ((q[0] + q[1]) + (q[2] + q[3])) * (1.f / 128.f);
                        r = scale * frsq(sq + EPS); }
                    const f32x4 v0 = acc[ai][bj][m][0] * r * gv[0], v1 = acc[ai][bj][m][1] * r * gv[1];
                    u32x4 w; w.x = cvtpk(v0[0], v0[1]); w.y = cvtpk(v0[2], v0[3]); w.z = cvtpk(v1[0], v1[1]); w.w = cvtpk(v1[2], v1[3]);
                    if (skip == 2) asm volatile("" :: "v"(w)); else *(u32x4*)(rowp + bj * 256) = w; } }
        if (mode != 0) EPI_BAR();
    }
};
struct SchedTiles {
    const char* A; const char* B; int nM, nN, lda, ldb, nt, G, c;
    __device__ __forceinline__ bool next(int i, Unit& u) const {
        const int L = i * G + c; if (L >= nM * nN) return false;
        int pm, pn; pg8::tile_of(L, nM, nN, pm, pn); u.A = A + (size_t)pm * 256 * lda * 2; u.B = B + (size_t)pn * 256 * ldb * 2; u.nt = nt; u.pm = pm; u.pn = pn; u.kind = 0; return true;
    }
};
struct EpiGate {
    typedef EpiNoState State;
    bf16_t *OF, *OB, *NMQ; const float* gla_out_g; int skip;
    __device__ __forceinline__ void operator()(f32x4 (&acc)[2][2][4][2], const Unit& u, int wr, int wc, int fr_, int fq_, LAS unsigned char* le, State& est) const {
        if (skip == 1) { _Pragma("unroll") for (int a_ = 0; a_ < 2; ++a_) _Pragma("unroll") for (int m_ = 0; m_ < 4; ++m_) asm volatile("" :: "v"(acc[a_][0][m_][0]), "v"(acc[a_][0][m_][1]), "v"(acc[a_][1][m_][0]), "v"(acc[a_][1][m_][1])); return; }
        const int fr = (int)opaque((unsigned)fr_), fq = (int)opaque((unsigned)fq_);
        const int pn = u.pn; const int cw = wc * 32 + 8 * fq;
        const unsigned vo = opaque((unsigned)((wr * 64 + fr) * 1024 + cw) * 2u);
        if (pn < 4) {
            char* of = (char*)OF + ((size_t)u.pm * 256 * 1024 + pn * 256) * 2; const char* ob = (const char*)OB + ((size_t)u.pm * 256 * 1024 + pn * 256) * 2;
            LAS float* Pl = (LAS float*)le;
            u32x4 tp[8][2];
            u32x4 la[8][2], lb[8][2];
            constexpr int PD = 3;
#pragma unroll
            for (int g = 0; g < PD; ++g)
#pragma unroll
                for (int bj = 0; bj < 2; ++bj) { la[g][bj] = *(const u32x4*)(of + GOFF(g) + bj * 256 + vo); lb[g][bj] = *(const u32x4*)(ob + GOFF(g) + bj * 256 + vo); }
#pragma unroll
            for (int g = 0; g < 8; ++g) { const int ai = g >> 2, m = g & 3;
                asm volatile("" : "+v"(acc[ai][0][m][0]), "+v"(acc[ai][0][m][1]), "+v"(acc[ai][1][m][0]), "+v"(acc[ai][1][m][1]) :: "memory");
                if (g + PD < 8) {
#pragma unroll
                    for (int bj = 0; bj < 2; ++bj) { la[g + PD][bj] = *(const u32x4*)(of + GOFF(g + PD) + bj * 256 + vo); lb[g + PD][bj] = *(const u32x4*)(ob + GOFF(g + PD) + bj * 256 + vo); } }
#pragma unroll
                for (int bj = 0; bj < 2; ++bj) { const u32x4 a = la[g][bj], b = lb[g][bj]; float sq = 0.f; u32x4 tw;
#pragma unroll
                    for (int e = 0; e < 4; ++e) { const float a0 = e < 2 ? acc[ai][bj][m][0][2 * e] : acc[ai][bj][m][1][2 * e - 4], a1 = e < 2 ? acc[ai][bj][m][0][2 * e + 1] : acc[ai][bj][m][1][2 * e - 3];
                        const float lo = bf_lo(a[e]) + bf_lo(b[e]), hi = bf_hi(a[e]) + bf_hi(b[e]); sq += lo * lo + hi * hi; tw[e] = cvtpk(lo * silu_f(a0), hi * silu_f(a1)); }
                    asm volatile("" : "+v"(tw), "+v"(sq));
                    tp[g][bj] = tw;
                    pg8::ssq_put(sq, ai * 128 + wr * 64 + m * 16 + fr, bj, wc, fq, Pl); }
                asm volatile("" ::: "memory"); }
            EPI_BAR();
            const LAS float* qb = Pl + (wr * 64 + fr) * 8; const unsigned vo2 = opaque(vo);
            f32x4 g0v[2], g1v[2];
#pragma unroll
            for (int bj = 0; bj < 2; ++bj) { g0v[bj] = *(const f32x4*)(gla_out_g + bj * 128 + cw); g1v[bj] = *(const f32x4*)(gla_out_g + bj * 128 + cw + 4); }
#pragma unroll
            for (int g = 0; g < 8; ++g) { const int ai = g >> 2, m = g & 3;
                asm volatile("" : "+v"(tp[g][0]), "+v"(tp[g][1]) :: "memory");
                const LAS float* q = qb + (ai * 128 + m * 16) * 8;
                const float rstd = frsq((((q[0] + q[1]) + (q[2] + q[3])) + ((q[4] + q[5]) + (q[6] + q[7]))) * (1.f / 256.f) + EPS);
#pragma unroll
                for (int bj = 0; bj < 2; ++bj) { const u32x4 x = tp[g][bj]; u32x4 w;
#pragma unroll
                    for (int e = 0; e < 4; ++e) { const float g0 = e < 2 ? g0v[bj][2 * e] : g1v[bj][2 * e - 4], g1 = e < 2 ? g0v[bj][2 * e + 1] : g1v[bj][2 * e - 3];
                        w[e] = cvtpk(bf_lo(x[e]) * rstd * g0, bf_hi(x[e]) * rstd * g1); }
                    if (skip == 2) asm volatile("" :: "v"(w)); else *(u32x4*)(of + GOFF(g) + bj * 256 + vo2) = w; }
                asm volatile("" ::: "memory"); }
            EPI_BAR();
        } else {
            char* o = (char*)NMQ + ((size_t)u.pm * 256 * 1024 + (pn - 4) * 256) * 2;
            u32x4 la[8][2]; constexpr int PD = 5;
#pragma unroll
            for (int g = 0; g < PD; ++g)
#pragma unroll
                for (int bj = 0; bj < 2; ++bj) la[g][bj] = *(const u32x4*)(o + GOFF(g) + bj * 256 + vo);
#pragma unroll
            for (int g = 0; g < 8; ++g) { const int ai = g >> 2, m = g & 3;
                asm volatile("" : "+v"(acc[ai][0][m][0]), "+v"(acc[ai][0][m][1]), "+v"(acc[ai][1][m][0]), "+v"(acc[ai][1][m][1]) :: "memory");
                if (g + PD < 8) {
#pragma unroll
                    for (int bj = 0; bj < 2; ++bj) la[g + PD][bj] = *(const u32x4*)(o + GOFF(g + PD) + bj * 256 + vo); }
#pragma unroll
                for (int bj = 0; bj < 2; ++bj) { const u32x4 a = la[g][bj]; u32x4 w;
#pragma unroll
                    for (int e = 0; e < 4; ++e) { const float a0 = e < 2 ? acc[ai][bj][m][0][2 * e] : acc[ai][bj][m][1][2 * e - 4], a1 = e < 2 ? acc[ai][bj][m][0][2 * e + 1] : acc[ai][bj][m][1][2 * e - 3];
                        w[e] = cvtpk(bf_lo(a[e]) * silu_f(a0), bf_hi(a[e]) * silu_f(a1)); }
                    if (skip == 2) asm volatile("" :: "v"(w)); else *(u32x4*)(o + GOFF(g) + bj * 256 + vo) = w; }
                asm volatile("" ::: "memory"); }
        }
    }
};
struct SchedP3 {
    const char *H, *OA, *NMQ, *W; int G, c;
    __device__ __forceinline__ bool next(int i, Unit& u) const {
        const int ti = i / 6, seg = i - ti * 6; const int L = ti * G + c; if (L >= 512) return false;
        int pm, pn; pg8::tile_of(L, 128, 4, pm, pn);
        const char* a; int koff, nt;
        switch (seg) { case 0: a = H; koff = 0; nt = 16; break; case 1: a = OA; koff = 1024; nt = 16; break; case 2: a = H; koff = 2048; nt = 16; break;
                       case 3: a = NMQ; koff = 3072; nt = 8; break; case 4: a = H; koff = 3584; nt = 16; break; default: a = NMQ + 512 * 2; koff = 4608; nt = 8; break; }
        u.A = a + (size_t)pm * 256 * 1024 * 2; u.B = W + ((size_t)pn * 256 * KP3 + koff) * 2; u.nt = nt; u.pm = pm; u.pn = pn; u.kind = seg; return true;
    }
};
struct EpiP3 {
    struct State { u32x2 gc[8][2]; };
    bf16_t* Y;
    __device__ __forceinline__ void operator()(f32x4 (&acc)[2][2][4][2], const Unit& u, int wr, int wc, int fr_, int fq_, LAS unsigned char* le, State& est) const {
        const int fr = (int)opaque((unsigned)fr_), fq = (int)opaque((unsigned)fq_);
        const int seg = u.kind;
        if ((seg & 1) == 0) {
#pragma unroll
            for (int ai = 0; ai < 2; ++ai)
#pragma unroll
                for (int m = 0; m < 4; ++m) { asm volatile("" : "+v"(acc[ai][0][m][0]), "+v"(acc[ai][0][m][1]), "+v"(acc[ai][1][m][0]), "+v"(acc[ai][1][m][1]) :: "memory");
#pragma unroll
                    for (int bj = 0; bj < 2; ++bj) { u32x2 w;
#pragma unroll
                        for (int n = 0; n < 2; ++n) { const f32x4 v = acc[ai][bj][m][n]; unsigned p = 0u;
                            p = __builtin_amdgcn_cvt_pk_u8_f32(sigmoid_f(v[0]) * 255.f, 0, p); p = __builtin_amdgcn_cvt_pk_u8_f32(sigmoid_f(v[1]) * 255.f, 1, p);
                            p = __builtin_amdgcn_cvt_pk_u8_f32(sigmoid_f(v[2]) * 255.f, 2, p); p = __builtin_amdgcn_cvt_pk_u8_f32(sigmoid_f(v[3]) * 255.f, 3, p);
                            w[n] = p; }
                        asm volatile("" : "+v"(w));
                        est.gc[ai * 4 + m][bj] = w; } }
        } else {
            const unsigned vo = opaque((unsigned)((wr * 64 + fr) * 1024 + wc * 32 + 8 * fq) * 2u);
            char* yb = (char*)Y + ((size_t)u.pm * 256 * 1024 + u.pn * 256) * 2;
            u32x4 ly[8][2]; constexpr int PD = 3; constexpr float K = 1.0f / 255.0f;
            if (seg > 1) {
#pragma unroll
                for (int g = 0; g < PD; ++g)
#pragma unroll
                    for (int bj = 0; bj < 2; ++bj) ly[g][bj] = *(const u32x4*)(yb + GOFF(g) + bj * 256 + vo); }
#pragma unroll
            for (int g = 0; g < 8; ++g) { const int ai = g >> 2, m = g & 3;
                asm volatile("" : "+v"(acc[ai][0][m][0]), "+v"(acc[ai][0][m][1]), "+v"(acc[ai][1][m][0]), "+v"(acc[ai][1][m][1]), "+v"(est.gc[g][0]), "+v"(est.gc[g][1]) :: "memory");
#pragma unroll
                for (int bj = 0; bj < 2; ++bj) { const unsigned a0 = est.gc[g][bj][0], a1 = est.gc[g][bj][1]; const f32x4 v0 = acc[ai][bj][m][0], v1 = acc[ai][bj][m][1];
                    float o[8] = {v0[0] * ((float)(a0 & 0xffu) * K), v0[1] * ((float)((a0 >> 8) & 0xffu) * K), v0[2] * ((float)((a0 >> 16) & 0xffu) * K), v0[3] * ((float)(a0 >> 24) * K),
                                  v1[0] * ((float)(a1 & 0xffu) * K), v1[1] * ((float)((a1 >> 8) & 0xffu) * K), v1[2] * ((float)((a1 >> 16) & 0xffu) * K), v1[3] * ((float)(a1 >> 24) * K)};
                    if (seg > 1) { const u32x4 p = ly[g][bj];
                        o[0] += bf_lo(p.x); o[1] += bf_hi(p.x); o[2] += bf_lo(p.y); o[3] += bf_hi(p.y); o[4] += bf_lo(p.z); o[5] += bf_hi(p.z); o[6] += bf_lo(p.w); o[7] += bf_hi(p.w); }
                    u32x4 w; w.x = cvtpk(o[0], o[1]); w.y = cvtpk(o[2], o[3]); w.z = cvtpk(o[4], o[5]); w.w = cvtpk(o[6], o[7]);
                    *(u32x4*)(yb + GOFF(g) + bj * 256 + vo) = w; }
                if (seg > 1 && g + PD < 8) {
#pragma unroll
                    for (int bj = 0; bj < 2; ++bj) ly[g + PD][bj] = *(const u32x4*)(yb + GOFF(g + PD) + bj * 256 + vo); }
                asm volatile("" ::: "memory"); }
        }
    }
};
struct EpiP4 {
    typedef EpiNoState State;
    const float* xin; float* out;
    __device__ __forceinline__ void operator()(f32x4 (&acc)[2][2][4][2], const Unit& u, int wr, int wc, int fr_, int fq_, LAS unsigned char* le, State& est) const {
        const int fr = (int)opaque((unsigned)fr_), fq = (int)opaque((unsigned)fq_);
        const unsigned vo = opaque((unsigned)((wr * 64 + fr) * 1024 + wc * 32 + 8 * fq) * 4u);
        const size_t ubo = ((size_t)u.pm * 256 * 1024 + u.pn * 256) * 4; const char* xb = (const char*)xin + ubo; char* ob = (char*)out + ubo;
        f32x4 lx[8][2][2]; constexpr int PD = 3;
#pragma unroll
        for (int g = 0; g < PD; ++g)
#pragma unroll
            for (int bj = 0; bj < 2; ++bj)
#pragma unroll
                for (int n = 0; n < 2; ++n) lx[g][bj][n] = *(const f32x4*)(xb + 2 * GOFF(g) + vo + bj * 512 + 16 * n);
#pragma unroll
        for (int g = 0; g < 8; ++g) { const int ai = g >> 2, m = g & 3;
            asm volatile("" : "+v"(acc[ai][0][m][0]), "+v"(acc[ai][0][m][1]), "+v"(acc[ai][1][m][0]), "+v"(acc[ai][1][m][1]) :: "memory");
#pragma unroll
            for (int bj = 0; bj < 2; ++bj)
#pragma unroll
                for (int n = 0; n < 2; ++n) *(f32x4*)(ob + 2 * GOFF(g) + vo + bj * 512 + 16 * n) = lx[g][bj][n] + acc[ai][bj][m][n];
            if (g + PD < 8) {
#pragma unroll
                for (int bj = 0; bj < 2; ++bj)
#pragma unroll
                    for (int n = 0; n < 2; ++n) lx[g + PD][bj][n] = *(const f32x4*)(xb + 2 * GOFF(g + PD) + vo + bj * 512 + 16 * n); }
            asm volatile("" ::: "memory"); }
    }
};

__device__ __forceinline__ void glaprep_phase(const Ptrs& P, int l, LAS unsigned char* lds, int bx, int G, const int wv, const int probe) {
    const int tid = tid_of(wv), lane = tid & 63, w = __builtin_amdgcn_readfirstlane(tid >> 6), li = lane & 15, q4 = lane >> 4;
    constexpr int PSTR = 132, PTAB = 64 * PSTR * 4;
    const int st_tok = 8 * w + (lane >> 3), st_c = lane & 7;
    const unsigned lo_row = (unsigned)(st_tok * 1024 + st_c * 16);
    const unsigned lo_g = (unsigned)(li * 64 + 8 * q4) * 2u;
    char* GQb = (char*)(P.ws + WS_GQ); char* GKb = (char*)(P.ws + WS_GK); char* QBb = (char*)(P.ws + WS_QEB); char* KBb = (char*)(P.ws + WS_KEB);
    char* QFb = probe ? QBb : GQb; char* KFb = probe ? KBb : GKb;
    const char* GLb = (const char*)(P.ws + WS_GLR);
    float* DEC = (float*)(P.ws + WS_DEC);
#define PRE_S1(ga_, w2B_, bk_, BCd_, decp_, REV) do { f32x4 z_[4]; \
        _Pragma("unroll") for (int tt = 0; tt < 4; ++tt) z_[tt] = mfma16(ga_[tt], w2B_, (f32x4){bk_, bk_, bk_, bk_}); \
        float pv_[4][4], tot_[4]; \
        _Pragma("unroll") for (int tt = 0; tt < 4; ++tt) { float v_[4]; float run_ = 0.f; \
            _Pragma("unroll") for (int r = 0; r < 4; ++r) { const float zz = z_[tt][r]; const float ls2 = fminf(zz, 0.f) * LOG2E - __builtin_amdgcn_logf(1.f + fexp2(-fabsf(zz) * LOG2E)); \
                if (REV) v_[r] = run_; run_ += ls2 * (1.f / 16.f); if (!(REV)) v_[r] = run_; } \
              \
            const unsigned xb_ = __builtin_bit_cast(unsigned, run_); auto a_ = __builtin_amdgcn_permlane16_swap(xb_, xb_, false, false); \
            const float nb_ = __builtin_bit_cast(float, (q4 & 1) ? a_[0] : a_[1]); const float p_ = run_ + nb_; \
            const unsigned pb_ = __builtin_bit_cast(unsigned, p_); auto b_ = __builtin_amdgcn_permlane32_swap(pb_, pb_, false, false); \
            const float op_ = __builtin_bit_cast(float, (q4 & 2) ? b_[0] : b_[1]); \
            const float excl_ = ((q4 & 2) ? op_ : 0.f) + ((q4 & 1) ? nb_ : 0.f); tot_[tt] = p_ + op_; \
            _Pragma("unroll") for (int r = 0; r < 4; ++r) pv_[tt][r] = excl_ + v_[r]; } \
        const float o1_ = tot_[0], o2_ = o1_ + tot_[1], o3_ = o2_ + tot_[2], off_ = o3_ + tot_[3]; \
        _Pragma("unroll") for (int tt = 0; tt < 4; ++tt) { const float ot_ = tt == 0 ? 0.f : tt == 1 ? o1_ : tt == 2 ? o2_ : o3_; \
            _Pragma("unroll") for (int r = 0; r < 4; ++r) BCd_[(16 * tt + 4 * q4 + r) * PSTR + 16 * w + li] = (REV) ? off_ - (ot_ + pv_[tt][r]) : ot_ + pv_[tt][r]; } \
        if (q4 == 0) (decp_)[16 * w + li] = fexp2(off_); } while (0)
#define PRE_S2(BCd_, QEd_, KEd_) do { \
        _Pragma("unroll") for (int p_ = 0; p_ < 2; ++p_) { const LAS f32x4* bp = (const LAS f32x4*)(BCd_ + st_tok * PSTR + (st_c + 8 * p_) * 8); \
            const f32x4 b0 = bp[0], b1 = bp[1]; u32x4 qe, ke; \
            _Pragma("unroll") for (int e = 0; e < 4; ++e) { const float bl = e < 2 ? b0[2 * e] : b1[2 * e - 4], bh_ = e < 2 ? b0[2 * e + 1] : b1[2 * e - 3]; \
                const float el = fexp2(bl), eh = fexp2(bh_), il = fexp2(-bl), ih = fexp2(-bh_); \
                qe[e] = cvtpk(bf_lo(qv[p_][e]) * el, bf_hi(qv[p_][e]) * eh); ke[e] = cvtpk(bf_lo(kv[p_][e]) * il, bf_hi(kv[p_][e]) * ih); } \
            *(u32x4*)((QEd_) + uo + (size_t)p_ * 128 + lo_row) = qe; *(u32x4*)((KEd_) + uo + (size_t)p_ * 128 + lo_row) = ke; } } while (0)
    int par = 0;
#pragma unroll 1
    for (int u = bx; u < NB * 4 * 64; u += G) {
        const int ca = u & 63, h = (u >> 6) & 3, b = u >> 8;
        LAS float* BC0 = (LAS float*)(lds + par * 2 * PTAB); LAS float* BC1 = (LAS float*)(lds + par * 2 * PTAB + PTAB); par ^= 1;
        const float* w2f = P.w2f + (size_t)l * 16 * 512 + h * 128; const float* w2b = P.w2b + (size_t)l * 16 * 512 + h * 128;
        bf16x8 w2Bf, w2Bb; { unsigned pf[4], pb[4];
#pragma unroll
            for (int e = 0; e < 4; ++e) { const int r0 = (8 * q4 + 2 * e) & 15; pf[e] = cvtpk(w2f[r0 * 512 + 16 * w + li], w2f[(r0 + 1) * 512 + 16 * w + li]); pb[e] = cvtpk(w2b[r0 * 512 + 16 * w + li], w2b[(r0 + 1) * 512 + 16 * w + li]); }
            const u32x4 tf = {pf[0], pf[1], pf[2], pf[3]}, tb = {pb[0], pb[1], pb[2], pb[3]}; w2Bf = __builtin_bit_cast(bf16x8, tf); w2Bb = __builtin_bit_cast(bf16x8, tb); }
        const float bkf = P.bf[(size_t)l * 512 + h * 128 + 16 * w + li], bkb = P.bb[(size_t)l * 512 + h * 128 + 16 * w + li];
        const size_t tok0 = (size_t)b * SEQ + ca * 64;
        const size_t uo = tok0 * 1024 + h * 256;
        bf16x8 gaf[4], gab[4]; u32x4 qv[2], kv[2];
#pragma unroll
        for (int tt = 0; tt < 4; ++tt) { gaf[tt] = *(const bf16x8*)(GLb + (tok0 + 16 * tt) * 128 + lo_g); gab[tt] = *(const bf16x8*)(GLb + (tok0 + 16 * tt) * 128 + 64 + lo_g); }
#pragma unroll
        for (int p_ = 0; p_ < 2; ++p_) { qv[p_] = *(const u32x4*)(GQb + uo + (size_t)p_ * 128 + lo_row); kv[p_] = *(const u32x4*)(GKb + uo + (size_t)p_ * 128 + lo_row); }
        float* decf = DEC + ((size_t)((0 * NB + b) * 4 + h) * 64 + ca) * 128; float* decb = DEC + ((size_t)((1 * NB + b) * 4 + h) * 64 + ca) * 128;
        PRE_S1(gaf, w2Bf, bkf, BC0, decf, 0);
        PRE_S1(gab, w2Bb, bkb, BC1, decb, 1);
        asm volatile("s_waitcnt lgkmcnt(0)" ::: "memory"); __builtin_amdgcn_s_barrier(); asm volatile("" ::: "memory");
        PRE_S2(BC0, QFb, KFb);
        PRE_S2(BC1, QBb, KBb);
    }
#undef PRE_S1
#undef PRE_S2
}

constexpr int GL_BUF = 41984, GL_KEO = 16384, GL_VO = 32768, GL_DECO = 40960, GL_SB = 2 * GL_BUF, GL_XCH = GL_SB + 2 * 16384;
static_assert(GL_XCH + 2 * 8192 <= LDS_CTLW, "gla lds");
__device__ __forceinline__ int sw256(int row, int c) { return row * 256 + ((c ^ (row & 15)) << 4); }
__device__ __forceinline__ int sw128v(int row, int c) { return row * 128 + ((c ^ (((row >> 1) & 3) << 1)) << 4); }
__device__ __forceinline__ int sw128s(int row, int c) { return row * 128 + ((c ^ ((((row >> 1) & 1) | (((row >> 3) & 1) << 1)) << 1)) << 4); }
#define BAR_LDS() do { asm volatile("s_waitcnt lgkmcnt(0)" ::: "memory"); __builtin_amdgcn_s_barrier(); asm volatile("" ::: "memory"); } while (0)
__device__ __forceinline__ void gla_item(const Ptrs& P, int l, int item, LAS unsigned char* lds, const int wv) {
    const int tid = tid_of(wv), lane = tid & 63, w = __builtin_amdgcn_readfirstlane(tid >> 6), li = lane & 15, q4 = lane >> 4;
    const int xcd = item & 7, idx = item >> 3, bh = xcd * 4 + (idx >> 3), sub = idx & 7, j = sub & 3, dir = sub >> 2;
    const int b = bh >> 2, h = bh & 3;
    const char* QEb = (const char*)(P.ws + (dir ? WS_QEB : WS_GQ)) + ((size_t)b * SEQ * 512 + h * 128) * 2;
    const char* KEb = (const char*)(P.ws + (dir ? WS_KEB : WS_GK)) + ((size_t)b * SEQ * 512 + h * 128) * 2;
    const char* GVb = (const char*)(P.ws + WS_GV) + ((size_t)b * SEQ * 1024 + h * 256 + j * 64) * 2;
    char* Ob = (char*)(P.ws + (dir ? WS_OBW : WS_OF)) + ((size_t)b * SEQ * 1024 + h * 256 + j * 64) * 2;
    const float* DECb = (const float*)(P.ws + WS_DEC) + ((size_t)((dir * NB + b) * 4 + h) * 64) * 128;
    f32x4 ST[4];
#pragma unroll
    for (int k = 0; k < 4; ++k) ST[k] = (f32x4){0.f, 0.f, 0.f, 0.f};
    { LAS u32x4* z = (LAS u32x4*)(lds + GL_SB + 16384); const unsigned zz = opaque(0u); z[tid] = (u32x4){zz, zz, zz, zz}; z[tid + 512] = (u32x4){zz, zz, zz, zz}; }
    const int it = w >> 1, dt0 = (w & 1) * 2;
    const int sdt = w & 3, kt0 = (w >> 2) * 4;
    unsigned lo_d[2], lo_dv;
#pragma unroll
    for (int e = 0; e < 2; ++e) { const int tk = 8 * w + 4 * e + (lane >> 4), c16 = (lane & 15) ^ (tk & 15); lo_d[e] = (unsigned)((dir ? 63 - tk : tk) * 1024 + c16 * 16); }
    { const int row = 8 * w + (lane >> 3), c = (lane & 7) ^ (((row >> 1) & 3) << 1); lo_dv = (unsigned)((dir ? 63 - row : row) * 2048 + c * 16); }
#define GLA_DMA1(gb, vo, la) asm volatile("s_mov_b32 m0, %0\n\ts_nop 0\n\tglobal_load_lds_dwordx4 %1, %2" :: "s"((unsigned)(__UINTPTR_TYPE__)(la)), "v"(vo), "s"(gb) : "m0", "memory")
    const int dq0 = w == 1 ? 0 : w == 3 ? 4 : w == 0 ? 8 : w == 5 ? 9 : w == 2 ? 11 : w == 4 ? 12 : w == 6 ? 13 : 15;
    const int dqn = (w == 1 || w == 3) ? 4 : (w == 5 || w == 6) ? 2 : 1;
    const int dv0 = w == 0 ? 0 : w == 5 ? 1 : w == 2 ? 2 : w == 4 ? 4 : 6;
    const int dvn = (w == 1 || w == 3 || w == 6) ? 0 : (w == 0 || w == 5) ? 1 : 2;
#define GLA_DMA(cc, bo) do { const size_t ca_ = (size_t)(dir ? 63 - (cc) : (cc)) * 64; \
        for (int k_ = 0; k_ < dqn; ++k_) { const int i_ = dq0 + k_; const int tk_ = 4 * i_ + (lane >> 4); const unsigned o_ = (unsigned)((dir ? 63 - tk_ : tk_) * 1024 + (((lane & 15) ^ (tk_ & 15)) << 4)); \
            GLA_DMA1(QEb + ca_ * 1024, o_, lds + (bo) + i_ * 1024); GLA_DMA1(KEb + ca_ * 1024, o_, lds + (bo) + GL_KEO + i_ * 1024); } \
        for (int k_ = 0; k_ < dvn; ++k_) { const int i_ = dv0 + k_; const int row_ = 8 * i_ + (lane >> 3); const unsigned o_ = (unsigned)((dir ? 63 - row_ : row_) * 2048 + (((lane & 7) ^ (((row_ >> 1) & 3) << 1)) << 4)); \
            GLA_DMA1(GVb + ca_ * 2048, o_, lds + (bo) + GL_VO + i_ * 1024); } \
        if (w == 0) { unsigned long long sv_; asm volatile("s_mov_b64 %0, exec\n\ts_mov_b64 exec, 0xffffffff\n\ts_mov_b32 m0, %1\n\ts_nop 0\n\tglobal_load_lds_dwordx4 %2, %3\n\ts_mov_b64 exec, %0" \
            : "=&s"(sv_) : "s"((unsigned)(__UINTPTR_TYPE__)(lds + (bo) + GL_DECO)), "v"((unsigned)lane * 16u), "s"((const char*)DECb + ca_ * 8) : "m0", "memory"); } } while (0)
    GLA_DMA(0, 0);
    asm volatile("s_waitcnt vmcnt(0)" ::: "memory");
    __builtin_amdgcn_s_waitcnt(0x0F70);
    BAR_LDS();
    const int trr = (li >> 2), trc = ((li & 3) >> 1), trs = (li & 1) * 8;
    const int hf = w & 1; const bool act1 = 2 * hf <= it, act2 = 2 * hf + 1 <= it;
    const unsigned lo_o = (unsigned)((dir ? 63 - (16 * it + li) : 16 * it + li) * 1024 + 16 * dt0) * 2u + 16u * (unsigned)q4;
    f32x4 OTk[2] = {(f32x4){0.f, 0.f, 0.f, 0.f}, (f32x4){0.f, 0.f, 0.f, 0.f}};
#define GLA_FINAL(cc, xo) do { const u32x4 xp = *(const LAS u32x4*)(lds + GL_XCH + (xo) + (w ^ 1) * 1024 + lane * 16); \
          const size_t cb = (size_t)(dir ? 63 - (cc) : (cc)) * 64; u32x2 ov0, ov1; \
          ov0.x = cvtpk(OTk[0][0] + bf_lo(xp.x), OTk[0][1] + bf_hi(xp.x)); ov0.y = cvtpk(OTk[0][2] + bf_lo(xp.y), OTk[0][3] + bf_hi(xp.y)); \
          ov1.x = cvtpk(OTk[1][0] + bf_lo(xp.z), OTk[1][1] + bf_hi(xp.z)); ov1.y = cvtpk(OTk[1][2] + bf_lo(xp.w), OTk[1][3] + bf_hi(xp.w)); \
            \
          { auto r0 = __builtin_amdgcn_permlane32_swap(ov0.x, ov1.x, false, false); auto r1 = __builtin_amdgcn_permlane32_swap(ov0.y, ov1.y, false, false); \
            auto s0 = __builtin_amdgcn_permlane16_swap(r0[0], r0[1], false, false); auto s1 = __builtin_amdgcn_permlane16_swap(r1[0], r1[1], false, false); \
            const u32x4 ow = {s0[0], s1[0], s0[1], s1[1]}; *(u32x4*)(Ob + cb * 2048 + lo_o) = ow; } } while (0)
#pragma unroll 1
    for (int c2 = 0; c2 < 32; ++c2) {
#pragma unroll
      for (int sb = 0; sb < 2; ++sb) { const int c = 2 * c2 + sb; const int BO = sb * GL_BUF, SBR = GL_SB + (sb ^ 1) * 16384, SBW = GL_SB + sb * 16384, XR = (sb ^ 1) * 8192, XW = sb * 8192;
        if (c + 1 < 64) GLA_DMA(c + 1, (sb ^ 1) * GL_BUF);
        bf16x8 qb[4]; s16x4 sa[2][4][2]; s16x4 vi[4][2]; s16x4 vm[2][2]; s16x4 kb[4][2][2]; float dec[4]; bf16x8 ka1[4], ka2[4];
#pragma unroll
        for (int s = 0; s < 4; ++s) qb[s] = *(const LAS bf16x8*)(lds + BO + sw256(16 * it + li, 4 * s + q4));
#pragma unroll
        for (int dd = 0; dd < 2; ++dd)
#pragma unroll
            for (int s = 0; s < 4; ++s) { const int r0 = 32 * s + 8 * q4 + trr; const int cc = 2 * (dt0 + dd) + trc;
                sa[dd][s][0] = tr_read(lds + SBR + sw128s(r0, cc) + trs); sa[dd][s][1] = tr_read(lds + SBR + sw128s(r0 + 4, cc) + trs); }
        if (act1) {
#pragma unroll
            for (int s = 0; s < 4; ++s) ka1[s] = *(const LAS bf16x8*)(lds + BO + GL_KEO + sw256(32 * hf + li, 4 * s + q4)); }
        if (act2) {
#pragma unroll
            for (int s = 0; s < 4; ++s) ka2[s] = *(const LAS bf16x8*)(lds + BO + GL_KEO + sw256(32 * hf + 16 + li, 4 * s + q4)); }
        if (c > 0) GLA_FINAL(c - 1, XR);
        __builtin_amdgcn_sched_barrier(0);
        f32x4 OT[2] = {(f32x4){0.f, 0.f, 0.f, 0.f}, (f32x4){0.f, 0.f, 0.f, 0.f}};
#pragma unroll
        for (int s = 0; s < 4; ++s)
#pragma unroll
            for (int dd = 0; dd < 2; ++dd) OT[dd] = mfma16(cat44(sa[dd][s][0], sa[dd][s][1]), qb[s], OT[dd]);
        unsigned pk1[2] = {0u, 0u}, pk2[2] = {0u, 0u};
        if (act1) { f32x4 at = (f32x4){0.f, 0.f, 0.f, 0.f};
#pragma unroll
            for (int s = 0; s < 4; ++s) at = mfma16(ka1[s], qb[s], at);
            if (2 * hf == it) {
#pragma unroll
                for (int r = 0; r < 4; ++r) if (4 * q4 + r > li) at[r] = 0.f; }
            pk1[0] = cvtpk(at[0], at[1]); pk1[1] = cvtpk(at[2], at[3]); }
        if (act2) { f32x4 at = (f32x4){0.f, 0.f, 0.f, 0.f};
#pragma unroll
            for (int s = 0; s < 4; ++s) at = mfma16(ka2[s], qb[s], at);
            if (2 * hf + 1 == it) {
#pragma unroll
                for (int r = 0; r < 4; ++r) if (4 * q4 + r > li) at[r] = 0.f; }
            pk2[0] = cvtpk(at[0], at[1]); pk2[1] = cvtpk(at[2], at[3]); }
#pragma unroll
        for (int s = 0; s < 2; ++s) { const int r0 = 32 * s + 4 * q4 + trr; const int cc = 2 * sdt + trc;
            vm[s][0] = tr_read(lds + BO + GL_VO + sw128v(r0, cc) + trs); vm[s][1] = tr_read(lds + BO + GL_VO + sw128v(r0 + 16, cc) + trs); }
#pragma unroll
        for (int kk = 0; kk < 4; ++kk) { const int kt = kt0 + kk; dec[kk] = *(const LAS float*)(lds + BO + GL_DECO + (16 * kt + li) * 4);
#pragma unroll
            for (int s = 0; s < 2; ++s) { const int r0 = 32 * s + 4 * q4 + trr; const int cc = 2 * kt + trc;
                kb[kk][s][0] = tr_read(lds + BO + GL_KEO + sw256(r0, cc) + trs); kb[kk][s][1] = tr_read(lds + BO + GL_KEO + sw256(r0 + 16, cc) + trs); } }
        if (act1) {
#pragma unroll
            for (int dt = 0; dt < 4; ++dt) { const int r0 = 32 * hf + 4 * q4 + trr; const int cc = 2 * dt + trc;
                vi[dt][0] = tr_read(lds + BO + GL_VO + sw128v(r0, cc) + trs); vi[dt][1] = tr_read(lds + BO + GL_VO + sw128v(r0 + 16, cc) + trs); } }
        __builtin_amdgcn_sched_barrier(0);
#pragma unroll
        for (int kk = 0; kk < 4; ++kk) {
#pragma unroll
            for (int s = 0; s < 2; ++s) ST[kk] = mfma16(cat44(vm[s][0], vm[s][1]), cat44(kb[kk][s][0], kb[kk][s][1]), ST[kk]);
            ST[kk] = ST[kk] * dec[kk]; }
        f32x4 IP[4] = {(f32x4){0.f, 0.f, 0.f, 0.f}, (f32x4){0.f, 0.f, 0.f, 0.f}, (f32x4){0.f, 0.f, 0.f, 0.f}, (f32x4){0.f, 0.f, 0.f, 0.f}};
        if (act1) { const u32x4 bw = {pk1[0], pk1[1], pk2[0], pk2[1]}; const bf16x8 bfr = __builtin_bit_cast(bf16x8, bw);
#pragma unroll
            for (int dt = 0; dt < 4; ++dt) IP[dt] = mfma16(cat44(vi[dt][0], vi[dt][1]), bfr, IP[dt]); }
        { const f32x4 s0 = hf ? IP[0] : IP[2], s1 = hf ? IP[1] : IP[3];
          const u32x4 xw = {cvtpk(s0[0], s0[1]), cvtpk(s0[2], s0[3]), cvtpk(s1[0], s1[1]), cvtpk(s1[2], s1[3])};
          *(LAS u32x4*)(lds + GL_XCH + XW + w * 1024 + lane * 16) = xw; }
        OTk[0] = OT[0] + (hf ? IP[2] : IP[0]); OTk[1] = OT[1] + (hf ? IP[3] : IP[1]);
#pragma unroll
        for (int kk = 0; kk < 4; ++kk) { const int kr = 16 * (kt0 + kk) + li; u32x2 sv; sv.x = cvtpk(ST[kk][0], ST[kk][1]); sv.y = cvtpk(ST[kk][2], ST[kk][3]);
            *(LAS u32x2*)(lds + SBW + sw128s(kr, 2 * sdt + (q4 >> 1)) + (q4 & 1) * 8) = sv; }
        if (c > 0) asm volatile("s_waitcnt vmcnt(1)" ::: "memory"); else asm volatile("s_waitcnt vmcnt(0)" ::: "memory");
        BAR_LDS();
      }
    }
    GLA_FINAL(63, 8192);
#undef GLA_FINAL
#undef GLA_DMA1
#undef GLA_DMA
}

constexpr int NA_K = 0, NA_V = 73728, NA_RPB = 147456, NA_XCH = 149504;
__device__ __forceinline__ int swk128(int row, int c) { return row * 128 + ((c ^ ((row >> 1) & 7)) << 4); }
__device__ __forceinline__ int swv128(int row, int c) { return row * 128 + ((c ^ (row & 6)) << 4); }
__device__ __forceinline__ void na_item(const Ptrs& P, int l, int item, LAS unsigned char* lds, const int wv, bool do_store = true) {
    const int tid = tid_of(wv), lane = tid & 63, w = __builtin_amdgcn_readfirstlane(tid >> 6), li = lane & 15, q4 = lane >> 4;
    const int rg = item & 3, h = (item >> 2) & 7, b = item >> 5;
    const int r0 = rg * 16;
    const int t = w & 3, dh = w >> 2;
    const int c0 = t == 0 ? 0 : (t == 1 ? 8 : (t == 2 ? 24 : 32));
    char* NMQb = (char*)(P.ws + WS_NMQ) + ((size_t)b * SEQ * 1024 + h * 64) * 2;
    const char* NKb = (const char*)(P.ws + WS_NK) + ((size_t)b * SEQ * 512 + h * 64) * 2; const char* NVb = (const char*)(P.ws + WS_NV) + ((size_t)b * SEQ * 512 + h * 64) * 2;
    const int qc = 16 * t + li;
    const unsigned lo_q = (unsigned)(qc * 1024 + 8 * q4) * 2u;
    const unsigned lo_o = (unsigned)(qc * 1024 + 32 * dh) * 2u + 16u * (unsigned)q4;
    const int fk = tid >> 3, fc = tid & 7;
    const unsigned lo_f = (unsigned)(fk * 512 + fc * 8) * 2u;
    int rs = min(max(r0 - 4, 0), 56);
    struct NaPre { bf16x8 q[2]; u32x4 kv, vv; };
    NaPre S0, S1, S2;
#define NA_ISSUE(S, rr) do { const int rq_ = min((rr), 63); const int rk_ = min(max(rq_ - 4, 0), 56) + 7; \
        _Pragma("unroll") for (int s = 0; s < 2; ++s) (S).q[s] = *(const bf16x8*)(NMQb + (size_t)rq_ * 64 * 2048 + lo_q + s * 64); \
        (S).kv = *(const u32x4*)(NKb + (size_t)rk_ * 64 * 1024 + lo_f); (S).vv = *(const u32x4*)(NVb + (size_t)rk_ * 64 * 1024 + lo_f); } while (0)
    NA_ISSUE(S0, r0);
#pragma unroll
    for (int i = 0; i < 8; ++i) { const int ar = rs + i; const int slot = ar % 9; const size_t ro = (size_t)ar * 64 * 1024;
        const u32x4 kv = *(const u32x4*)(NKb + ro + lo_f), vv = *(const u32x4*)(NVb + ro + lo_f);
        *(LAS u32x4*)(lds + NA_K + slot * 8192 + swk128(fk, fc)) = kv; *(LAS u32x4*)(lds + NA_V + slot * 8192 + swv128(fk, fc)) = vv; }
    LAS float* RP = (LAS float*)(lds + NA_RPB);
    if (tid < 465) RP[tid] = P.rpb[((size_t)l * 8 + h) * 465 + tid] * LOG2E;
    asm volatile("s_waitcnt vmcnt(0)" ::: "memory");
    BAR_LDS();
    NA_ISSUE(S1, r0 + 1);
    const int cs = min(max(qc - 8, 0), 48);
    const int trr = li >> 2, trc = (li & 3) >> 1, trs = (li & 1) * 8;
    const int bh = dh;
    float bc_[4][2][4]; int cur_off = 1000;
    LAS unsigned char* xo_mine = lds + NA_XCH + w * 1024 + lane * 16; LAS unsigned char* xr_mine = lds + NA_XCH + 8192 + w * 256 + lane * 4;
    const LAS unsigned char* xo_part = lds + NA_XCH + (w ^ 4) * 1024 + lane * 16; const LAS unsigned char* xr_part = lds + NA_XCH + 8192 + (w ^ 4) * 256 + lane * 4;
    auto step = [&](NaPre& C, NaPre& A, NaPre& B, const int i) __attribute__((always_inline)) {
        const int r = r0 + i;
        if (rs - r != cur_off) { cur_off = rs - r;
#pragma unroll
            for (int sp = 0; sp < 4; ++sp) { const int drow = (cur_off + 4 * bh + sp + 7) * 31;
#pragma unroll
                for (int e = 0; e < 2; ++e)
#pragma unroll
                    for (int rr = 0; rr < 4; ++rr) { const int kcol = c0 + 16 * e + 4 * q4 + rr; const bool ok = (kcol >= cs) && (kcol < cs + 16);
                        const int dc = min(max(kcol - qc + 15, 0), 30); const float b_ = RP[drow + dc]; bc_[sp][e][rr] = ok ? b_ : -1e30f; } } }
        const int rsn = min(max(r + 1 - 4, 0), 56); const bool newrow = (i < 15) && (rsn != rs);
        NA_ISSUE(B, r + 2);
        f32x4 OT[4] = {(f32x4){0.f, 0.f, 0.f, 0.f}, (f32x4){0.f, 0.f, 0.f, 0.f}, (f32x4){0.f, 0.f, 0.f, 0.f}, (f32x4){0.f, 0.f, 0.f, 0.f}}; float rsum = 0.f;
        bf16x8 ka[4][2][2]; s16x4 va[4][4][2];
        { int slot = (rs + 4 * bh) % 9; int slots[4];
#pragma unroll
          for (int sp = 0; sp < 4; ++sp) { slots[sp] = slot; slot = slot == 8 ? 0 : slot + 1; }
#pragma unroll
          for (int sp = 0; sp < 4; ++sp) { const LAS unsigned char* kb_ = lds + NA_K + slots[sp] * 8192;
#pragma unroll
            for (int e = 0; e < 2; ++e)
#pragma unroll
                for (int s = 0; s < 2; ++s) ka[sp][e][s] = *(const LAS bf16x8*)(kb_ + swk128(c0 + 16 * e + li, 4 * s + q4)); }
#pragma unroll
          for (int sp = 0; sp < 4; ++sp) { const LAS unsigned char* vb_ = lds + NA_V + slots[sp] * 8192;
#pragma unroll
            for (int dt = 0; dt < 4; ++dt) { const int k0r = c0 + 4 * q4 + trr; const int cc = 2 * dt + trc;
                va[sp][dt][0] = tr_read(vb_ + swv128(k0r, cc) + trs); va[sp][dt][1] = tr_read(vb_ + swv128(k0r + 16, cc) + trs); } } }
        __builtin_amdgcn_sched_barrier(0);
#pragma unroll
        for (int sp = 0; sp < 4; ++sp) {
            unsigned pk[2][2];
#pragma unroll
            for (int e = 0; e < 2; ++e) { f32x4 sc = (f32x4){0.f, 0.f, 0.f, 0.f};
#pragma unroll
                for (int s = 0; s < 2; ++s) sc = mfma16(ka[sp][e][s], C.q[s], sc);
                float p[4];
#pragma unroll
                for (int rr = 0; rr < 4; ++rr) { p[rr] = fexp2(sc[rr] + bc_[sp][e][rr]); rsum += p[rr]; }
                pk[e][0] = cvtpk(p[0], p[1]); pk[e][1] = cvtpk(p[2], p[3]); }
            const u32x4 bw = {pk[0][0], pk[0][1], pk[1][0], pk[1][1]}; const bf16x8 bfr = __builtin_bit_cast(bf16x8, bw);
#pragma unroll
            for (int dt = 0; dt < 4; ++dt) OT[dt] = mfma16(cat44(va[sp][dt][0], va[sp][dt][1]), bfr, OT[dt]);
        }
        rsum += bperm(rsum, lane ^ 16); rsum += bperm(rsum, lane ^ 32);
        { const f32x4 s0 = bh ? OT[0] : OT[2], s1 = bh ? OT[1] : OT[3];
          const u32x4 xw = {cvtpk(s0[0], s0[1]), cvtpk(s0[2], s0[3]), cvtpk(s1[0], s1[1]), cvtpk(s1[2], s1[3])};
          *(LAS u32x4*)xo_mine = xw; *(LAS float*)xr_mine = rsum; }
        BAR_LDS();
        const u32x4 xp = *(const LAS u32x4*)xo_part; const float rtot = rsum + *(const LAS float*)xr_part;
        const f32x4 m0 = bh ? OT[2] : OT[0], m1 = bh ? OT[3] : OT[1];
        const float inv = frcp(rtot);
        u32x2 ov0, ov1;
        ov0.x = cvtpk((m0[0] + bf_lo(xp.x)) * inv, (m0[1] + bf_hi(xp.x)) * inv); ov0.y = cvtpk((m0[2] + bf_lo(xp.y)) * inv, (m0[3] + bf_hi(xp.y)) * inv);
        ov1.x = cvtpk((m1[0] + bf_lo(xp.z)) * inv, (m1[1] + bf_hi(xp.z)) * inv); ov1.y = cvtpk((m1[2] + bf_lo(xp.w)) * inv, (m1[3] + bf_hi(xp.w)) * inv);
        if (newrow) { const int slot_n = (rs + 8) % 9; *(LAS u32x4*)(lds + NA_K + slot_n * 8192 + swk128(fk, fc)) = A.kv; *(LAS u32x4*)(lds + NA_V + slot_n * 8192 + swv128(fk, fc)) = A.vv; }
        { auto r0 = __builtin_amdgcn_permlane32_swap(ov0.x, ov1.x, false, false); auto r1 = __builtin_amdgcn_permlane32_swap(ov0.y, ov1.y, false, false);
          auto s0 = __builtin_amdgcn_permlane16_swap(r0[0], r0[1], false, false); auto s1 = __builtin_amdgcn_permlane16_swap(r1[0], r1[1], false, false);
          const u32x4 ow = {s0[0], s1[0], s0[1], s1[1]};
          if (do_store) *(u32x4*)(NMQb + (size_t)r * 64 * 2048 + lo_o) = ow; else asm volatile("" :: "v"(ow)); }
        BAR_LDS();
        rs = rsn;
    };
#pragma unroll 1
    for (int i3 = 0; i3 < 15; i3 += 3) { step(S0, S1, S2, i3); step(S1, S2, S0, i3 + 1); step(S2, S0, S1, i3 + 2); }
    step(S0, S1, S2, 15);
#undef NA_ISSUE
}

constexpr int MA_K = 0, MA_V = 65536;
__device__ __forceinline__ int swm(int row, int c) { return row * 256 + ((c ^ (row & 15)) << 4); }
__device__ __forceinline__ int swmv(int row, int c) { return row * 256 + ((c ^ ((row & 7) << 1)) << 4); }
__device__ __forceinline__ void ma_item(const Ptrs& P, int item, LAS unsigned char* lds, const int wv, bool do_store = true) {
    const int tid = tid_of(wv), lane = tid & 63, w = __builtin_amdgcn_readfirstlane(tid >> 6), r32 = lane & 31, hi = lane >> 5, li = lane & 15, g = lane >> 4;
    const int qcx = item & 7, h = (item >> 3) & 3, b = item >> 5;
    const bf16_t* MK = (const bf16_t*)(P.ws + WS_MK) + (size_t)b * MEML * 512 + h * 128;
    const bf16_t* MV = (const bf16_t*)(P.ws + WS_MV) + (size_t)b * MEML * 512 + h * 128;
    bf16_t* MQ = (bf16_t*)(P.ws + WS_NMQ) + 512 + h * 128;
#pragma unroll
    for (int i = 0; i < 8; ++i) { const int ch = tid + i * 512; const int key = ch >> 4, c = ch & 15;
        const u32x4 kv = *(const u32x4*)(MK + (size_t)key * 512 + c * 8), vv = *(const u32x4*)(MV + (size_t)key * 512 + c * 8);
        *(LAS u32x4*)(lds + MA_K + swm(key, c)) = kv; *(LAS u32x4*)(lds + MA_V + swmv(key, c)) = vv; }
    __syncthreads();
    const int kx = r32 & 15; const int kro = r32 * 256;
    const int vrow = 4 * hi + (li >> 2); const int vx = (vrow & 7) << 1; const int vc0 = 2 * (g & 1) + ((li & 3) >> 1); const int vro = vrow * 256 + (li & 1) * 8;
    int voff[4];
#pragma unroll
    for (int d = 0; d < 4; ++d) voff[d] = vro + (((4 * d + vc0) ^ vx) << 4);
    for (int si = 0; si < 2; ++si) {
        const size_t q0 = (size_t)b * SEQ + qcx * 512 + (w * 2 + si) * 32;
        bf16x8 qf[8];
#pragma unroll
        for (int s = 0; s < 8; ++s) qf[s] = *(const bf16x8*)(MQ + (q0 + r32) * 1024 + 16 * s + 8 * hi);
        f32x16 O[4];
#pragma unroll
        for (int d = 0; d < 4; ++d)
#pragma unroll
            for (int e = 0; e < 16; ++e) O[d][e] = 0.f;
        float rsum = 0.f;
#pragma unroll 1
        for (int kt = 0; kt < 8; ++kt) {
            const LAS unsigned char* kp = lds + MA_K + kt * 8192 + kro; const LAS unsigned char* vp = lds + MA_V + kt * 8192;
            bf16x8 ka[8]; s16x4 va[2][4][2];
#pragma unroll
            for (int s = 0; s < 8; ++s) ka[s] = *(const LAS bf16x8*)(kp + (((2 * s + hi) ^ kx) << 4));
#pragma unroll
            for (int s = 0; s < 2; ++s)
#pragma unroll
                for (int d = 0; d < 4; ++d) { va[s][d][0] = tr_read(vp + voff[d] + s * 4096); va[s][d][1] = tr_read(vp + voff[d] + s * 4096 + 2048); }
            f32x16 sc0, sc1;
#pragma unroll
            for (int e = 0; e < 16; ++e) { sc0[e] = 0.f; sc1[e] = 0.f; }
#pragma unroll
            for (int s = 0; s < 4; ++s) { sc0 = mfma32(ka[2 * s], qf[2 * s], sc0); sc1 = mfma32(ka[2 * s + 1], qf[2 * s + 1], sc1); }
            unsigned pw[8];
#pragma unroll
            for (int e = 0; e < 8; ++e) { const float p0 = fexp2(sc0[2 * e] + sc1[2 * e]), p1 = fexp2(sc0[2 * e + 1] + sc1[2 * e + 1]); rsum += p0 + p1; pw[e] = cvtpk(p0, p1); }
#pragma unroll
            for (int s = 0; s < 2; ++s) { const u32x4 bw = {pw[4 * s], pw[4 * s + 1], pw[4 * s + 2], pw[4 * s + 3]}; const bf16x8 bfr = __builtin_bit_cast(bf16x8, bw);
#pragma unroll
                for (int d = 0; d < 4; ++d) O[d] = mfma32(cat44(va[s][d][0], va[s][d][1]), bfr, O[d]); }
        }
        rsum += bperm(rsum, lane ^ 32);
        const float inv = 1.0f / rsum;
#pragma unroll
        for (int d = 0; d < 4; ++d)
#pragma unroll
            for (int g4 = 0; g4 < 4; g4 += 2) {
                u32x2 a, b; a.x = cvtpk(O[d][4 * g4] * inv, O[d][4 * g4 + 1] * inv); a.y = cvtpk(O[d][4 * g4 + 2] * inv, O[d][4 * g4 + 3] * inv);
                b.x = cvtpk(O[d][4 * g4 + 4] * inv, O[d][4 * g4 + 5] * inv); b.y = cvtpk(O[d][4 * g4 + 6] * inv, O[d][4 * g4 + 7] * inv);
                auto rx = __builtin_amdgcn_permlane32_swap(a.x, b.x, false, false); auto ry = __builtin_amdgcn_permlane32_swap(a.y, b.y, false, false);
                const u32x4 ow = {rx[0], ry[0], rx[1], ry[1]};
                if (do_store) *(u32x4*)(MQ + (q0 + r32) * 1024 + 32 * d + 8 * g4 + 8 * hi) = ow; else asm volatile("" :: "v"(ow)); }
    }
    __syncthreads();
}

#define XB_TMO      128
#define XB_XCNT(j)  (256  + 64 * (j))
#define XB_XSUB(j)  (1280 + 64 * (j))
#define XB_XGEN(j)  (2304 + 64 * (j))
#define XB_TOP      3328
#define XB_TOPGEN   3392
#define XCD_BAR_WORDS 3456
#define XB_SPIN_CAP (1u << 18)

__device__ __forceinline__ unsigned xb_ld(unsigned* p)              { return __hip_atomic_load(p, __ATOMIC_RELAXED, __HIP_MEMORY_SCOPE_AGENT); }
__device__ __forceinline__ unsigned xb_add(unsigned* p, unsigned v) { return __hip_atomic_fetch_add(p, v, __ATOMIC_RELAXED, __HIP_MEMORY_SCOPE_AGENT); }
__device__ __forceinline__ unsigned xb_xcc_id() { return (unsigned)__builtin_amdgcn_s_getreg((3 << 11) | 20) & 0xFu; }
#define XB_SPIN(cond, bar) do { unsigned _sp = 0; while (cond) { __builtin_amdgcn_s_sleep(1); \
    if ((++_sp & 255u) == 0u) { if (xb_ld(&(bar)[XB_TMO])) break; if (_sp > XB_SPIN_CAP) { atomicAdd(&(bar)[XB_TMO], 1u); break; } } } } while (0)

struct XcdBarrier {
    unsigned* bar; unsigned x;
    volatile LAS unsigned* st;
};

__device__ __forceinline__ XcdBarrier xcd_barrier_post(unsigned* bar, volatile LAS unsigned* st, const int wv) {
    XcdBarrier b; b.bar = bar; b.x = xb_xcc_id(); b.st = st;
    if (tid_of(wv) == 0) (void)xb_add(&bar[XB_XCNT(b.x)], 1u);
    return b;
}
__device__ __forceinline__ void xcd_barrier_complete(unsigned* bar, unsigned x, unsigned& nloc, unsigned& nx) {
    const unsigned G = gridDim.x * gridDim.y * gridDim.z;
    unsigned sum, cnt, mine, sp = 0u;
    for (;;) {
        sum = 0u; cnt = 0u; mine = 0u;
#pragma unroll
        for (unsigned j = 0; j < 16; ++j) { const unsigned c = xb_ld(&bar[XB_XCNT(j)]); sum += c; cnt += (c > 0u) ? 1u : 0u; mine = (j == x) ? c : mine; }
        if (sum == G) break;
        __builtin_amdgcn_s_sleep(1);
        if ((++sp & 255u) == 0u) { if (xb_ld(&bar[XB_TMO])) break; if (sp > XB_SPIN_CAP) { atomicAdd(&bar[XB_TMO], 1u); break; } }
    }
    nloc = mine > 0u ? mine : 1u; nx = cnt > 0u ? cnt : 1u;
}

__device__ __forceinline__ void xcd_barrier(const XcdBarrier& b, const int wv) {
    asm volatile("s_waitcnt vmcnt(0)" ::: "memory");
    __syncthreads();
    if (tid_of(wv) == 0) {
        unsigned* bar = b.bar;
        __builtin_amdgcn_s_waitcnt(0);
        unsigned nloc = b.st[0], nx = b.st[1];
        if (nloc == 0u) { xcd_barrier_complete(bar, b.x, nloc, nx); b.st[0] = nloc; b.st[1] = nx; }
        const unsigned old = xb_add(&bar[XB_XSUB(b.x)], 1u);
        const unsigned gen = old / nloc;
        if (old + 1u == (gen + 1u) * nloc) {
            __builtin_amdgcn_fence(__ATOMIC_RELEASE, "agent");
            asm volatile("s_waitcnt vmcnt(0)" ::: "memory");
            const unsigned og = xb_add(&bar[XB_TOP], 1u);
            const unsigned tg = og / nx;
            if (og + 1u == (tg + 1u) * nx) xb_add(&bar[XB_TOPGEN], 1u);
            else XB_SPIN(xb_ld(&bar[XB_TOPGEN]) == tg, bar);
            __builtin_amdgcn_fence(__ATOMIC_ACQUIRE, "agent");
            xb_add(&bar[XB_XGEN(b.x)], 1u);
            asm volatile("s_waitcnt vmcnt(0)" ::: "memory");
        } else {
            XB_SPIN(xb_ld(&bar[XB_XGEN(b.x)]) == gen, bar);
            __builtin_amdgcn_fence(__ATOMIC_ACQUIRE, "agent");
            asm volatile("s_waitcnt vmcnt(0)" ::: "memory");
        }
    }
    __syncthreads();
}


constexpr int PH_PER_LAYER = 7, N_PHASES = DEPTH * PH_PER_LAYER;
__global__ void __launch_bounds__(NTHR, 2) fwd_kernel(Args args) {
    extern __shared__ __attribute__((aligned(16))) unsigned char lds_raw[];
    LAS unsigned char* lds = (LAS unsigned char*)lds_raw;
    Ptrs P;
    P.x = args.in[0]; P.mem = args.in[1]; P.norm_g = args.in[2]; P.w_in = args.in[3]; P.w2f = args.in[4]; P.bf = args.in[5]; P.w2b = args.in[6]; P.bb = args.in[7];
    P.gla_out_g = args.in[8]; P.p_a = args.in[9]; P.na_q_g = args.in[10]; P.na_k_g = args.in[11]; P.rpb = args.in[12]; P.p_b = args.in[13]; P.mem_norm_g = args.in[14];
    P.w_mem = args.in[15]; P.mem_q_g = args.in[16]; P.mem_k_g = args.in[17]; P.p_c = args.in[18]; P.w_out = args.in[19]; P.out = args.out; P.ws = args.ws;
    const int G = gridDim.x, bx0 = blockIdx.x;
    const int vcu = (G % 8 == 0) ? (bx0 % 8) * (G / 8) + bx0 / 8 : bx0;
    unsigned char* ws = args.ws;
    volatile LAS unsigned* ctlw = (volatile LAS unsigned*)(lds + LDS_CTLW);
    const int wv = __builtin_amdgcn_readfirstlane((int)(threadIdx.x >> 6));
    if (threadIdx.x < 16) ctlw[threadIdx.x] = 0u;
    __syncthreads();
    XcdBarrier bar; bar.bar = (unsigned*)(ws + WS_CTL); bar.x = 0; bar.st = nullptr;
    if (args.ph_hi - args.ph_lo > 1) bar = xcd_barrier_post((unsigned*)(ws + WS_CTL), ctlw, wv);
    for (int ph = args.ph_lo; ph < args.ph_hi; ++ph) {
        int l = ph / PH_PER_LAYER, p = ph % PH_PER_LAYER; asm volatile("" : "+s"(l), "+s"(p));
        const float* xin = l == 0 ? P.x : P.out;
        int bx = bx0; asm volatile("" : "+s"(bx));
        { GAS unsigned char* w_ = (GAS unsigned char*)args.ws; asm volatile("" : "+s"(w_)); ws = (unsigned char*)w_; P.ws = ws; }
        for (int rep = 0; rep < ((PROBE_REP >= 0 && PROBE_REP < 10 && PROBE_REP == p && l == 0) ? 2 : 1); ++rep) {
#ifndef ONLY_PHASE
#define ONLY_PHASE -1
#endif
#define PHSEL(k) (p == (k) && (ONLY_PHASE < 0 || ONLY_PHASE == (k)))
        if (PHSEL(0)) {
            p0_phase(P, l, lds, vcu, G, xin, wv);
        } else if (PHSEL(1)) {
            SchedP1 S{(const char*)(ws + WS_H), (const char*)(ws + WS_WIN), (const char*)(ws + WS_HMEM), (const char*)(ws + WS_WMEM), G, bx};
            if ((PROBE_REP == 11 || PROBE_REP == 12) && l == 0) { EpiP1 E0{ws, P.na_q_g + l * 64, P.na_k_g + l * 64, P.mem_q_g + l * 128, P.mem_k_g + l * 128, PROBE_REP - 10}; pg8::gemm_phase<EpiP1, SchedP1>(lds, 1024, 1024, S, E0, wv); }
            EpiP1 E{ws, P.na_q_g + l * 64, P.na_k_g + l * 64, P.mem_q_g + l * 128, P.mem_k_g + l * 128, 0};
            pg8::gemm_phase<EpiP1, SchedP1>(lds, 1024, 1024, S, E, wv);
        } else if (PHSEL(2)) {
            for (int st = 0; st < 2; ++st) {
                if ((st ^ ((0x22 >> (bx & 7)) & 1)) == 0) {
                    for (int it = bx; it < NB * 8 * 4; it += G) na_item(P, l, it, lds, wv);
                    for (int it = bx; it < NB * 4 * 8; it += G) ma_item(P, it, lds, wv);
                } else glaprep_phase(P, l, lds, bx, G, wv, 0);
                __syncthreads();
            }
        } else if (PHSEL(3)) {
            { int nrep = (PROBE_REP == 40 && l == 0) ? 2 : 1; asm volatile("" : "+s"(nrep));
              for (int rr = 0; rr < nrep; ++rr) for (int it = bx; it < 256; it += G) gla_item(P, l, it, lds, wv); }
        } else if (PHSEL(4)) {
            SchedTiles S{(const char*)(ws + WS_H), (const char*)(ws + WS_WGATE), 128, 8, 1024, 1024, 16, G, bx};
            if ((PROBE_REP == 13 || PROBE_REP == 17) && l == 0) { EpiGate E0{(bf16_t*)(ws + WS_OF), (bf16_t*)(ws + WS_OBW), (bf16_t*)(ws + WS_NMQ), P.gla_out_g + l * 256, PROBE_REP == 13 ? 1 : 2}; pg8::gemm_phase<EpiGate, SchedTiles>(lds, 1024, 1024, S, E0, wv); }
            EpiGate E{(bf16_t*)(ws + WS_OF), (bf16_t*)(ws + WS_OBW), (bf16_t*)(ws + WS_NMQ), P.gla_out_g + l * 256, 0};
            pg8::gemm_phase<EpiGate, SchedTiles>(lds, 1024, 1024, S, E, wv);
        } else if (PHSEL(5)) {
            SchedP3 S{(const char*)(ws + WS_H), (const char*)(ws + WS_OF), (const char*)(ws + WS_NMQ), (const char*)(ws + WS_WP3), G, bx};
            EpiP3 E{(bf16_t*)(ws + WS_Y)};
            pg8::gemm_phase<EpiP3, SchedP3>(lds, 1024, KP3, S, E, wv);
        } else if (PHSEL(6)) {
            SchedTiles S{(const char*)(ws + WS_Y), (const char*)(ws + WS_WOUT), 128, 4, 1024, 1024, 16, G, bx};
            EpiP4 E{xin, P.out};
            pg8::gemm_phase<EpiP4, SchedTiles>(lds, 1024, 1024, S, E, wv);
        }
        }
        if (ph + 1 < args.ph_hi) { xcd_barrier(bar, wv); }
    }
}

extern "C" void kernel_launch(void* const* d_in, const int* in_sizes, int n_in, void* d_out, int out_size, void* d_ws, size_t ws_size, hipStream_t stream) {
    static int grid = 0;
    if (grid == 0) {
        if (n_in != 20 || out_size != T * DM || ws_size < WS_END) { fprintf(stderr, "kernel_launch: unexpected problem (n_in %d out %d ws %zu)\n", n_in, out_size, ws_size); grid = -1; return; }
        int dev = 0, cus = 0, per_cu = 0;
        hipGetDevice(&dev); hipDeviceGetAttribute(&cus, hipDeviceAttributeMultiprocessorCount, dev);
        hipFuncSetAttribute((const void*)fwd_kernel, hipFuncAttributeMaxDynamicSharedMemorySize, LDS_BYTES);
        hipOccupancyMaxActiveBlocksPerMultiprocessor(&per_cu, (const void*)fwd_kernel, NTHR, LDS_BYTES);
        (void)hipGetLastError();
        if (per_cu < 1) { fprintf(stderr, "kernel_launch: occupancy query says %d blocks/CU\n", per_cu); per_cu = 1; }
        grid = cus;
    }
    if (grid < 0) return;
    Args a{};
    for (int i = 0; i < 20; ++i) a.in[i] = (const float*)d_in[i];
    a.out = (float*)d_out; a.ws = (unsigned char*)d_ws;
    if (MK_N_LAUNCHES == 1) {
        a.ph_lo = 0; a.ph_hi = N_PHASES;
        if (hipMemsetAsync((char*)d_ws + WS_CTL, 0, 65536, stream) != hipSuccess) { fprintf(stderr, "kernel_launch: memset of the barrier words failed\n"); return; }
        hipLaunchKernelGGL(fwd_kernel, dim3(grid), dim3(NTHR), LDS_BYTES, stream, a);
        const hipError_t e = hipPeekAtLastError();
        if (e != hipSuccess) fprintf(stderr, "launch failed: %s (grid %d)\n", hipGetErrorString(e), grid);
    } else {
        for (int ph = 0; ph < N_PHASES; ++ph) { a.ph_lo = ph; a.ph_hi = ph + 1; hipLaunchKernelGGL(fwd_kernel, dim3(grid), dim3(NTHR), LDS_BYTES, stream, a); }
    }
}
```

```cpp
#include <hip/hip_runtime.h>
#include <cstdio>
#include <cstdint>

#ifndef MK_N_LAUNCHES
#define MK_N_LAUNCHES 1
#endif

#ifndef PROBE_REP
#define PROBE_REP -1
#endif
#define LAS __attribute__((address_space(3)))
#define GAS __attribute__((address_space(1)))
typedef unsigned short bf16_t;
typedef short bf16x8 __attribute__((ext_vector_type(8)));
typedef short s16x4 __attribute__((ext_vector_type(4)));
typedef float f32x4 __attribute__((ext_vector_type(4)));
typedef float f32x16 __attribute__((ext_vector_type(16)));
typedef float f32x2 __attribute__((ext_vector_type(2)));
typedef unsigned u32x4 __attribute__((ext_vector_type(4)));
typedef unsigned u32x2 __attribute__((ext_vector_type(2)));
typedef __bf16 bf16x2_t __attribute__((ext_vector_type(2)));

constexpr int DM = 1024, NB = 8, SEQ = 4096, T = NB * SEQ, DEPTH = 2, MEML = 256, TMEM = NB * MEML;
constexpr int IN_COLS = 9248;
constexpr float EPS = 1e-6f, LOG2E = 1.4426950408889634f;
constexpr int NWAVES = 8, NTHR = 512;
constexpr int N1 = 4352;
constexpr int KP3 = 5120;

constexpr size_t MiB = 1u << 20;
constexpr size_t WS_CTL = 0;
constexpr size_t WS_WIN = 1 * MiB;
constexpr size_t WS_WGATE = WS_WIN + (size_t)N1 * 1024 * 2;
constexpr size_t WS_WP3 = WS_WGATE + (size_t)2048 * 1024 * 2;
constexpr size_t WS_WOUT = WS_WP3 + (size_t)1024 * KP3 * 2;
constexpr size_t WS_WMEM = WS_WOUT + (size_t)1024 * 1024 * 2;
constexpr size_t WS_HMEM = WS_WMEM + (size_t)1024 * 1024 * 2;
constexpr size_t WS_MK = WS_HMEM + (size_t)TMEM * 1024 * 2;
constexpr size_t WS_MV = WS_MK + (size_t)TMEM * 512 * 2;
constexpr size_t WS_GLR = WS_MV + (size_t)TMEM * 512 * 2;
constexpr size_t WS_H = 40 * MiB;
constexpr size_t WS_GQ = WS_H + 64 * MiB;
constexpr size_t WS_GK = WS_GQ + 32 * MiB;
constexpr size_t WS_GV = WS_GK + 32 * MiB;
constexpr size_t WS_NMQ = WS_GV + 64 * MiB;
constexpr size_t WS_NK = WS_NMQ + 64 * MiB;
constexpr size_t WS_NV = WS_NK + 32 * MiB;
constexpr size_t WS_OF = WS_NV + 32 * MiB;
constexpr size_t WS_OB = WS_OF + 64 * MiB;
constexpr size_t WS_DEC = WS_OB + 64 * MiB;
constexpr size_t WS_END = WS_DEC + 2 * MiB;
constexpr size_t WS_QEB = WS_OB, WS_KEB = WS_OB + 32 * MiB;
constexpr size_t WS_OBW = WS_NK;
constexpr size_t WS_Y = WS_GQ;
constexpr size_t WS_SG = WS_GV;
static_assert(WS_GLR + (size_t)T * 32 * 4 <= WS_H, "ws map");
static_assert(WS_END <= 512 * MiB, "ws map");

constexpr int LDS_EPI = 131072;
constexpr int LDS_CTLW = 159744;
constexpr int LDS_BYTES = 160768;

__device__ __forceinline__ unsigned cvtpk(float lo, float hi) { f32x2 v = {lo, hi}; bf16x2_t b = __builtin_convertvector(v, bf16x2_t); return __builtin_bit_cast(unsigned, b); }
__device__ __forceinline__ float bf_lo(unsigned u) { return __builtin_bit_cast(float, u << 16); }
__device__ __forceinline__ float bf_hi(unsigned u) { return __builtin_bit_cast(float, u & 0xffff0000u); }
__device__ __forceinline__ float fexp2(float x) { return __builtin_amdgcn_exp2f(x); }
__device__ __forceinline__ float frcp(float x) { return __builtin_amdgcn_rcpf(x); }
__device__ __forceinline__ float silu_f(float a) { return a * frcp(1.f + fexp2(-a * LOG2E)); }
__device__ __forceinline__ float sigmoid_f(float a) { return frcp(1.f + fexp2(-a * LOG2E)); }
__device__ __forceinline__ unsigned opaque(unsigned v) { asm volatile("" : "+v"(v)); return v; }
__device__ __forceinline__ float frsq(float x) { return __builtin_amdgcn_rsqf(x); }
__device__ __forceinline__ int tid_of(int wv) { unsigned l_; asm volatile("v_mbcnt_lo_u32_b32 %0, -1, 0\n\tv_mbcnt_hi_u32_b32 %0, -1, %0" : "=v"(l_)); return wv * 64 + (int)l_; }
__device__ __forceinline__ float bperm(float v, int src_lane) { return __builtin_bit_cast(float, __builtin_amdgcn_ds_bpermute(src_lane << 2, __builtin_bit_cast(int, v))); }
__device__ __forceinline__ float sum_x16(float v, int lane) { const unsigned b = __builtin_bit_cast(unsigned, v); auto a = __builtin_amdgcn_permlane16_swap(b, b, false, false); return v + __builtin_bit_cast(float, (lane & 16) ? a[0] : a[1]); }
__device__ __forceinline__ float sum_x32(float v, int lane) { const unsigned b = __builtin_bit_cast(unsigned, v); auto a = __builtin_amdgcn_permlane32_swap(b, b, false, false); return v + __builtin_bit_cast(float, (lane & 32) ? a[0] : a[1]); }
__device__ __forceinline__ float wave_sum(float v, int lane) {
#pragma unroll
    for (int o = 1; o < 16; o <<= 1) v += bperm(v, lane ^ o);
    v = sum_x32(sum_x16(v, lane), lane);
    return v;
}
__device__ __forceinline__ s16x4 tr_read(const LAS unsigned char* p) { return __builtin_bit_cast(s16x4, __builtin_amdgcn_ds_read_tr16_b64_v4i16((LAS s16x4*)p)); }
__device__ __forceinline__ bf16x8 cat44(s16x4 a, s16x4 b) { return (bf16x8){a[0], a[1], a[2], a[3], b[0], b[1], b[2], b[3]}; }
__device__ __forceinline__ f32x4 mfma16(bf16x8 a, bf16x8 b, f32x4 c) { return __builtin_amdgcn_mfma_f32_16x16x32_bf16(a, b, c, 0, 0, 0); }
__device__ __forceinline__ f32x16 mfma32(bf16x8 a, bf16x8 b, f32x16 c) { return __builtin_amdgcn_mfma_f32_32x32x16_bf16(a, b, c, 0, 0, 0); }

namespace pg8 {
constexpr int BM = 256, BK = 64, HALF = 128, HTB = HALF * BK * 2, STAGE_BYTES = 8 * HTB, NXCD = 8, WGM = 8;
__host__ __device__ __forceinline__ int lds_byte(int r, int c) { const int st = (r >> 4) * 2 + (c >> 5), rr = r & 15, cc = c & 31, ob = rr * 64 + cc * 2; return st * 1024 + (ob ^ (((ob >> 9) & 1) << 5)); }
__host__ __device__ __forceinline__ void stage_rc(int b, int& R, int& C) { const int st = b / 1024, sb = b % 1024, swz = sb ^ (((sb >> 9) & 1) << 5); R = (st >> 1) * 16 + swz / 64; C = (st & 1) * 32 + (swz % 64) / 2; }
__host__ __device__ __forceinline__ int perm32(int rho) { const int n = rho >> 4, i = rho & 15; return 8 * (i >> 2) + 4 * n + (i & 3); }

struct Unit { const char* A; const char* B; int nt; int pm, pn, kind; };
__device__ __forceinline__ void tile_of(int L, int nM, int nN, int& pm, int& pn) {
    const int nwg = nM * nN; int wgid = L; { const int q = nwg / NXCD, r = nwg % NXCD, xcd = wgid % NXCD, off = wgid / NXCD; wgid = (xcd < r ? xcd * (q + 1) : r * (q + 1) + (xcd - r) * q) + off; }
    const int nig = WGM * nN, gid = wgid / nig, fm = gid * WGM, gsz = (nM - fm) < WGM ? (nM - fm) : WGM;
    pm = fm + ((wgid % nig) % gsz); pn = (wgid % nig) / gsz;
}

template <class Epi, class Sched>
__device__ __forceinline__ void gemm_phase(LAS unsigned char* lds, const int lda, const int ldb, const Sched& S, const Epi& E, const int wv) {
    const int tid = tid_of(wv), wid = __builtin_amdgcn_readfirstlane(tid >> 6), lane = tid & 63, wr = wid >> 2, wc = wid & 3, fr = lane & 15, fq = lane >> 4;
    unsigned voffA[2], voffB[2];
#pragma unroll
    for (int i = 0; i < 2; ++i) { int R, C; stage_rc(tid * 16 + i * 8192, R, C); const int Rb = (R & ~31) + perm32(R & 31);
        voffA[i] = (unsigned)(R * lda + C) * 2u; voffB[i] = (unsigned)(Rb * ldb + C) * 2u; }
    const size_t kstep = (size_t)(BK * 2);
    const size_t hstepA = (size_t)HALF * lda * 2, hstepB = (size_t)HALF * ldb * 2;
    const unsigned ldsw = (unsigned)wid * 1024u;
    const int aoff = lds_byte(wr * 64 + fr, fq * 8), boff = lds_byte(wc * 32 + fr, fq * 8);
#define PG8_SA(b, h) (((b) * 2 + (h)) * HTB)
#define PG8_SB(b, h) ((4 + (b) * 2 + (h)) * HTB)
#define PG8_STAGE(bufoff, gbase, voff) do { _Pragma("unroll") for (int _i = 0; _i < 2; ++_i) \
        __builtin_amdgcn_global_load_lds((const unsigned*)((const char*)(gbase) + (voff)[_i]), (LAS unsigned*)(lds + (bufoff) + ldsw + _i * 8192), 16, 0, 0); } while (0)
#define PG8_LDA(dst, b, h) do { _Pragma("unroll") for (int m = 0; m < 4; ++m) _Pragma("unroll") for (int k = 0; k < 2; ++k) dst[m][k] = *(const LAS bf16x8*)(lds + PG8_SA(b, h) + aoff + m * 2048 + k * 1024); } while (0)
#define PG8_LDB(dst, b, h) do { _Pragma("unroll") for (int n = 0; n < 2; ++n) _Pragma("unroll") for (int k = 0; k < 2; ++k) dst[n][k] = *(const LAS bf16x8*)(lds + PG8_SB(b, h) + boff + n * 2048 + k * 1024); } while (0)
#define PG8_MMA(ai, bj, At, Bt) do { __builtin_amdgcn_s_setprio(1); _Pragma("unroll") for (int m = 0; m < 4; ++m) _Pragma("unroll") for (int n = 0; n < 2; ++n) _Pragma("unroll") for (int k = 0; k < 2; ++k) \
        acc[ai][bj][m][n] = __builtin_amdgcn_mfma_f32_16x16x32_bf16(Bt[n][k], At[m][k], acc[ai][bj][m][n], 0, 0, 0); __builtin_amdgcn_s_setprio(0); } while (0)
#define PG8_WAIT_V(n) asm volatile("s_waitcnt vmcnt(" #n ")" ::: "memory")
#define PG8_WAIT_L(n) asm volatile("s_waitcnt lgkmcnt(" #n ")" ::: "memory")
#define PG8_BAR __builtin_amdgcn_s_barrier()
#define PG8_SCHED __builtin_amdgcn_sched_barrier(0)
    Unit cur, nxt; int ui = 0;
    typename Epi::State est;
    if (!S.next(0, cur)) return;
    const char* cA = cur.A; const char* cB = cur.B;
    PG8_STAGE(PG8_SB(0, 0), cB, voffB); PG8_STAGE(PG8_SB(0, 1), cB + hstepB, voffB); PG8_STAGE(PG8_SA(0, 0), cA, voffA); PG8_STAGE(PG8_SA(0, 1), cA + hstepA, voffA);
    if (wr == 1) PG8_BAR;
    PG8_WAIT_V(2); PG8_BAR;
    PG8_STAGE(PG8_SB(1, 0), cB + kstep, voffB); PG8_STAGE(PG8_SA(1, 0), cA + kstep, voffA); PG8_STAGE(PG8_SB(1, 1), cB + hstepB + kstep, voffB);
    PG8_WAIT_V(0); PG8_BAR;
    asm volatile("" ::: "memory");
    f32x4 acc[2][2][4][2];
#pragma unroll
    for (int a = 0; a < 2; ++a)
#pragma unroll
        for (int b = 0; b < 2; ++b)
#pragma unroll
            for (int m = 0; m < 4; ++m)
#pragma unroll
                for (int n = 0; n < 2; ++n) acc[a][b][m][n] = (f32x4){0.f, 0.f, 0.f, 0.f};
    bf16x8 At[4][2], B0[2][2], B1[2][2];
    for (;;) {
        const bool has_next = S.next(ui + 1, nxt);
        const char* nA = has_next ? nxt.A : cA; const char* nB = has_next ? nxt.B : cB;
        const int nt = cur.nt;
        for (int t = 0; t < nt; t += 2) {
            const bool last = (t == nt - 2);
            const char* a1 = cA + (size_t)(t + 1) * kstep;
            const char* a2 = last ? nA : cA + (size_t)(t + 2) * kstep; const char* b2 = last ? nB : cB + (size_t)(t + 2) * kstep;
            const char* a3 = a2 + kstep; const char* b3 = b2 + kstep;
            int tz = t; asm volatile("" : "+s"(tz));
            PG8_LDB(B0, 0, 0); PG8_LDB(B1, 0, 1); PG8_SCHED; PG8_LDA(At, 0, 0); PG8_STAGE(PG8_SA(1, 1), a1 + hstepA, voffA);
            if (tz != 0) PG8_WAIT_V(8);
            PG8_WAIT_L(0); PG8_BAR; PG8_MMA(0, 0, At, B0); PG8_MMA(0, 1, At, B1); PG8_BAR; PG8_SCHED;
            PG8_LDA(At, 0, 1); PG8_STAGE(PG8_SB(0, 0), b2, voffB); PG8_STAGE(PG8_SB(0, 1), b2 + hstepB, voffB); PG8_STAGE(PG8_SA(0, 0), a2, voffA);
            if (tz != 0) PG8_WAIT_V(8);
            PG8_WAIT_L(0); PG8_BAR; PG8_MMA(1, 0, At, B0); PG8_MMA(1, 1, At, B1); PG8_BAR; PG8_SCHED;
            PG8_LDB(B0, 1, 0); PG8_LDB(B1, 1, 1); PG8_SCHED; PG8_LDA(At, 1, 0); PG8_STAGE(PG8_SA(0, 1), a2 + hstepA, voffA);
            PG8_WAIT_V(8); PG8_WAIT_L(0); PG8_BAR; PG8_MMA(0, 0, At, B0); PG8_MMA(0, 1, At, B1); PG8_BAR; PG8_SCHED;
            PG8_LDA(At, 1, 1); PG8_STAGE(PG8_SB(1, 0), b3, voffB); PG8_STAGE(PG8_SB(1, 1), b3 + hstepB, voffB); PG8_STAGE(PG8_SA(1, 0), a3, voffA);
            PG8_WAIT_V(8); PG8_WAIT_L(0); PG8_BAR; PG8_MMA(1, 0, At, B0); PG8_MMA(1, 1, At, B1); PG8_BAR; PG8_SCHED;
        }
        PG8_WAIT_V(0);
        if (wr == 0) PG8_BAR;
        E(acc, cur, wr, wc, fr, fq, lds + LDS_EPI, est);
        if (!has_next) break;
#pragma unroll
        for (int a = 0; a < 2; ++a)
#pragma unroll
            for (int b = 0; b < 2; ++b)
#pragma unroll
                for (int m = 0; m < 4; ++m)
#pragma unroll
                    for (int n = 0; n < 2; ++n) acc[a][b][m][n] = (f32x4){0.f, 0.f, 0.f, 0.f};
        cur = nxt; cA = nA; cB = nB; ++ui;
        if (wr == 1) PG8_BAR;
    }
    PG8_WAIT_V(0);
    PG8_BAR;
#undef PG8_SA
#undef PG8_SB
#undef PG8_STAGE
#undef PG8_LDA
#undef PG8_LDB
#undef PG8_MMA
}
#define GOFF(g) ((size_t)(((g) >> 2) * 128 + ((g) & 3) * 16) * 2048)
#define EPI_BAR() do { asm volatile("s_waitcnt lgkmcnt(0)" ::: "memory"); __builtin_amdgcn_s_barrier(); asm volatile("" ::: "memory"); } while (0)

__device__ __forceinline__ void ssq_put(float s, int rowt, int bj, int wc, int fq, LAS float* P) {
    const int ln_ = (rowt & 15) | (fq << 4);
    s = sum_x32(sum_x16(s, ln_), ln_);
    if (fq == 0) P[rowt * 8 + bj * 4 + wc] = s;
}
}
using pg8::Unit;

struct Args { const float* in[20]; float* out; unsigned char* ws; int ph_lo, ph_hi; };

struct Ptrs {
    const float *x, *mem, *norm_g, *w_in, *w2f, *bf, *w2b, *bb, *gla_out_g, *p_a, *na_q_g, *na_k_g, *rpb, *p_b, *mem_norm_g, *w_mem, *mem_q_g, *mem_k_g, *p_c, *w_out;
    float* out; unsigned char* ws;
};

__device__ __forceinline__ void p0_transpose_item(const float* W, int srcN, int c0, int ncols, bf16_t* WT, int row0, int ld, int koff, LAS float* scr, int item, int lane) {
    const int nblk = ncols / 32, kb = item / nblk, nb = item % nblk, k0 = 64 * kb, n0 = 32 * nb;
#pragma unroll 8
    for (int i = 0; i < 32; ++i) { const int kk = 2 * i + (lane >> 5); scr[kk * 33 + (lane & 31)] = W[(size_t)(k0 + kk) * srcN + c0 + n0 + (lane & 31)]; }
    asm volatile("s_waitcnt lgkmcnt(0)" ::: "memory");
    const int c = lane & 7;
#pragma unroll
    for (int j = 0; j < 4; ++j) { const int n = (lane >> 3) + 8 * j; const LAS float* s = scr + (8 * c) * 33 + n;
        u32x4 o; o.x = cvtpk(s[0 * 33], s[1 * 33]); o.y = cvtpk(s[2 * 33], s[3 * 33]); o.z = cvtpk(s[4 * 33], s[5 * 33]); o.w = cvtpk(s[6 * 33], s[7 * 33]);
        *(u32x4*)(WT + (size_t)(row0 + n0 + n) * ld + koff + k0 + 8 * c) = o; }
    asm volatile("s_waitcnt lgkmcnt(0)" ::: "memory");
}
__device__ __forceinline__ void rms_rows_to_bf16(const float* X, const float* g, bf16_t* O, int m0, int step, int nrows, int lane) {
    if (m0 >= nrows) return;
    const f32x4* gr = (const f32x4*)g + lane;
    f32x4 gg[4];
#pragma unroll
    for (int j = 0; j < 4; ++j) gg[j] = gr[64 * j];
    f32x4 vn[4];
    { const f32x4* xr = (const f32x4*)(X + (size_t)m0 * DM) + lane;
#pragma unroll
      for (int j = 0; j < 4; ++j) vn[j] = xr[64 * j]; }
    for (int m = m0; m < nrows; m += step) {
        f32x4 v[4];
#pragma unroll
        for (int j = 0; j < 4; ++j) v[j] = vn[j];
        if (m + step < nrows) { const f32x4* xr = (const f32x4*)(X + (size_t)(m + step) * DM) + lane;
#pragma unroll
            for (int j = 0; j < 4; ++j) vn[j] = xr[64 * j]; }
        float sq = 0.f;
#pragma unroll
        for (int j = 0; j < 4; ++j) sq += (v[j].x * v[j].x + v[j].y * v[j].y) + (v[j].z * v[j].z + v[j].w * v[j].w);
        const float rstd = 1.0f / sqrtf(wave_sum(sq, lane) * (1.f / DM) + EPS);
        u32x2* o8 = (u32x2*)(O + (size_t)m * DM) + lane;
#pragma unroll
        for (int j = 0; j < 4; ++j) { u32x2 w; w.x = cvtpk(v[j].x * rstd * gg[j].x, v[j].y * rstd * gg[j].y); w.y = cvtpk(v[j].z * rstd * gg[j].z, v[j].w * rstd * gg[j].w); o8[64 * j] = w; }
    }
}
struct Seg { int src, srcN, c0, ncols, K, dst, row0, ld, koff; };
__device__ __forceinline__ void p0_phase(const Ptrs& P, int l, LAS unsigned char* lds, int vcu, int G, const float* xin, const int wv) {
    const int tid = tid_of(wv), lane = tid & 63, wave = tid >> 6;
    LAS float* scr = (LAS float*)(lds + wave * 16384);
    const int gw = vcu * NWAVES + wave, NGW = G * NWAVES;
    constexpr int NSEG = 19;
    const Seg segs[NSEG] = {
        {0, IN_COLS, 0, 512, 1024, 0, 0, 1024, 0},
        {0, IN_COLS, 512, 512, 1024, 0, 512, 1024, 0},
        {0, IN_COLS, 1024, 1024, 1024, 0, 1024, 1024, 0},
        {0, IN_COLS, 3104, 512, 1024, 0, 2048, 1024, 0},
        {0, IN_COLS, 3616, 512, 1024, 0, 2560, 1024, 0},
        {0, IN_COLS, 4128, 512, 1024, 0, 3072, 1024, 0},
        {0, IN_COLS, 5152, 512, 1024, 0, 3584, 1024, 0},
        {0, IN_COLS, 3072, 32, 1024, 0, 4096, 1024, 0},
        {0, IN_COLS, 2048, 1024, 1024, 1, 0, 1024, 0},
        {0, IN_COLS, 4640, 512, 1024, 1, 1024, 1024, 0},
        {0, IN_COLS, 5664, 512, 1024, 1, 1536, 1024, 0},
        {0, IN_COLS, 6176, 1024, 1024, 2, 0, KP3, 0},
        {0, IN_COLS, 7200, 1024, 1024, 2, 0, KP3, 2048},
        {0, IN_COLS, 8224, 1024, 1024, 2, 0, KP3, 3584},
        {1, 1024, 0, 1024, 1024, 2, 0, KP3, 1024},
        {2, 1024, 0, 1024, 512, 2, 0, KP3, 3072},
        {3, 1024, 0, 1024, 512, 2, 0, KP3, 4608},
        {4, 1024, 0, 1024, 1024, 3, 0, 1024, 0},
        {5, 1024, 0, 1024, 1024, 4, 0, 1024, 0},
    };
    int total = 0;
#pragma unroll
    for (int s = 0; s < NSEG; ++s) total += (segs[s].K / 64) * (segs[s].ncols / 32);
    for (int it = gw; it < total; it += NGW) {
        int r = it;
#pragma unroll
        for (int s = 0; s < NSEG; ++s) {
            const int n = (segs[s].K / 64) * (segs[s].ncols / 32);
            if (r >= 0 && r < n) {
                const float* src = segs[s].src == 0 ? P.w_in + (size_t)l * 1024 * IN_COLS : segs[s].src == 1 ? P.p_a + (size_t)l * 1024 * 1024 : segs[s].src == 2 ? P.p_b + (size_t)l * 512 * 1024 :
                                   segs[s].src == 3 ? P.p_c + (size_t)l * 512 * 1024 : segs[s].src == 4 ? P.w_out + (size_t)l * 1024 * 1024 : P.w_mem + (size_t)l * 1024 * 1024;
                bf16_t* dst = (bf16_t*)(P.ws + (segs[s].dst == 0 ? WS_WIN : segs[s].dst == 1 ? WS_WGATE : segs[s].dst == 2 ? WS_WP3 : segs[s].dst == 3 ? WS_WOUT : WS_WMEM));
                p0_transpose_item(src, segs[s].srcN, segs[s].c0, segs[s].ncols, dst, segs[s].row0, segs[s].ld, segs[s].koff, scr, r, lane);
            }
            r -= n;
        }
    }
    { u32x4* z = (u32x4*)(P.ws + WS_WIN + (size_t)4128 * 1024 * 2); const int nz = 224 * 1024 * 2 / 16;
      const unsigned zz = opaque(0u);
      for (int i = vcu * NTHR + tid; i < nz; i += G * NTHR) z[i] = (u32x4){zz, zz, zz, zz}; }
    bf16_t* H = (bf16_t*)(P.ws + WS_H);
    rms_rows_to_bf16(xin, P.norm_g + l * DM, H, gw, NGW, T, lane);
    bf16_t* HM = (bf16_t*)(P.ws + WS_HMEM);
    rms_rows_to_bf16(P.mem, P.mem_norm_g + l * DM, HM, gw, NGW, TMEM, lane);
}

struct SchedP1 {
    const char* H; const char* W; const char* HM; const char* WM; int G, c;
    __device__ __forceinline__ bool next(int i, Unit& u) const {
        const int L = i * G + c; constexpr int NMAIN = 128 * 17;
        const bool mainu = L < NMAIN; const int r = L - NMAIN;
        if (!mainu && r >= 32) return false;
        int pm, pn; pg8::tile_of(mainu ? L : 0, 128, 17, pm, pn);
        if (!mainu) { pm = r >> 2; pn = r & 3; }
        const char* a = mainu ? H : HM; const char* b = mainu ? W : WM;
        Unit t; t.A = a + (size_t)pm * 256 * 1024 * 2; t.B = b + (size_t)pn * 256 * 1024 * 2; t.nt = 16; t.pm = pm; t.pn = pn; t.kind = mainu ? 0 : 1; u = t; return true;
    }
};
struct EpiNoState {};
struct EpiP1 {
    typedef EpiNoState State;
    unsigned char* ws; const float *na_q_g, *na_k_g, *mem_q_g, *mem_k_g; int skip;
    __device__ __forceinline__ void operator()(f32x4 (&acc)[2][2][4][2], const Unit& u, int wr, int wc, int fr_, int fq_, LAS unsigned char* le, State& est) const {
        if (skip == 1) { _Pragma("unroll") for (int a_ = 0; a_ < 2; ++a_) _Pragma("unroll") for (int m_ = 0; m_ < 4; ++m_) asm volatile("" :: "v"(acc[a_][0][m_][0]), "v"(acc[a_][0][m_][1]), "v"(acc[a_][1][m_][0]), "v"(acc[a_][1][m_][1])); return; }
        const int fr = (int)opaque((unsigned)fr_), fq = (int)opaque((unsigned)fq_);
        bf16_t* dst; int ldc, col0, mode = 0; float scale = 1.f; const float* gain = nullptr;
        const int pn = u.pn;
        bf16_t* const GQ = (bf16_t*)(ws + WS_GQ); bf16_t* const GK = (bf16_t*)(ws + WS_GK); bf16_t* const GV = (bf16_t*)(ws + WS_GV); bf16_t* const NMQ = (bf16_t*)(ws + WS_NMQ);
        bf16_t* const NK = (bf16_t*)(ws + WS_NK); bf16_t* const NV = (bf16_t*)(ws + WS_NV); bf16_t* const MK = (bf16_t*)(ws + WS_MK); bf16_t* const MV = (bf16_t*)(ws + WS_MV); float* const GLR = (float*)(ws + WS_GLR);
        if (u.kind == 0) {
            if (pn < 2) { dst = GQ; ldc = 512; col0 = pn * 256; scale = 0.08838834764831845f; }
            else if (pn < 4) { dst = GK; ldc = 512; col0 = (pn - 2) * 256; }
            else if (pn < 8) { dst = GV; ldc = 1024; col0 = (pn - 4) * 256; }
            else if (pn < 10) { dst = NMQ; ldc = 1024; col0 = (pn - 8) * 256; mode = 1; gain = na_q_g; scale = 0.125f * LOG2E; }
            else if (pn < 12) { dst = NK; ldc = 512; col0 = (pn - 10) * 256; mode = 1; gain = na_k_g; }
            else if (pn < 14) { dst = NV; ldc = 512; col0 = (pn - 12) * 256; }
            else if (pn < 16) { dst = NMQ; ldc = 1024; col0 = 512 + (pn - 14) * 256; mode = 2; gain = mem_q_g; scale = 0.08838834764831845f * LOG2E; }
            else { dst = nullptr; ldc = 0; col0 = 0; mode = 3; }
        } else {
            if (pn < 2) { dst = MK; ldc = 512; col0 = pn * 256; mode = 2; gain = mem_k_g; }
            else { dst = MV; ldc = 512; col0 = (pn - 2) * 256; }
        }
        if (mode == 3) {
            if (wc == 0) { const unsigned vo = opaque((unsigned)((wr * 64 + fr) * 64 + (fq >> 1) * 32 + (fq & 1) * 8) * 2u); char* ub = (char*)GLR + (size_t)u.pm * 256 * 64 * 2;
#pragma unroll
                for (int ai = 0; ai < 2; ++ai)
#pragma unroll
                    for (int m = 0; m < 4; ++m) { char* rp = ub + (ai * 128 + m * 16) * 64 * 2 + vo; const f32x4 a = acc[ai][0][m][0], b = acc[ai][0][m][1];
                        u32x4 hi; hi.x = cvtpk(a[0], a[1]); hi.y = cvtpk(a[2], a[3]); hi.z = cvtpk(b[0], b[1]); hi.w = cvtpk(b[2], b[3]);
                        u32x4 lo; lo.x = cvtpk(a[0] - bf_lo(hi.x), a[1] - bf_hi(hi.x)); lo.y = cvtpk(a[2] - bf_lo(hi.y), a[3] - bf_hi(hi.y)); lo.z = cvtpk(b[0] - bf_lo(hi.z), b[1] - bf_hi(hi.z)); lo.w = cvtpk(b[2] - bf_lo(hi.w), b[3] - bf_hi(hi.w));
                        *(u32x4*)rp = hi; *(u32x4*)(rp + 32) = lo; }
            }
            return;
        }
        f32x4 gv[2] = {(f32x4){1.f, 1.f, 1.f, 1.f}, (f32x4){1.f, 1.f, 1.f, 1.f}};
        LAS float* Pl = (LAS float*)le;
        if (mode != 0) {
#pragma unroll
            for (int ai = 0; ai < 2; ++ai)
#pragma unroll
                for (int m = 0; m < 4; ++m)
#pragma unroll
                    for (int bj = 0; bj < 2; ++bj) { const f32x4 a = acc[ai][bj][m][0], b = acc[ai][bj][m][1];
                        pg8::ssq_put((a.x * a.x + a.y * a.y) + (a.z * a.z + a.w * a.w) + (b.x * b.x + b.y * b.y) + (b.z * b.z + b.w * b.w), ai * 128 + wr * 64 + m * 16 + fr, bj, wc, fq, Pl); }
            EPI_BAR();
            const int gc = (mode == 1 ? (wc & 1) * 32 : wc * 32) + 8 * fq;
            gv[0] = *(const f32x4*)(gain + gc); gv[1] = *(const f32x4*)(gain + gc + 4);
        }
        const unsigned vo = opaque((unsigned)((wr * 64 + fr) * ldc + wc * 32 + 8 * fq) * 2u);
        char* ub = (char*)dst + ((size_t)u.pm * 256 * ldc + col0) * 2;
        const LAS float* qb = Pl + (wr * 64 + fr) * 8;
#pragma unroll
        for (int ai = 0; ai < 2; ++ai)
#pragma unroll
            for (int m = 0; m < 4; ++m) { asm volatile("" : "+v"(acc[ai][0][m][0]), "+v"(acc[ai][0][m][1]), "+v"(acc[ai][1][m][0]), "+v"(acc[ai][1][m][1]) :: "memory"); char* rowp = ub + (size_t)((ai * 128 + m * 16) * ldc) * 2 + vo;
#pragma unroll
                for (int bj = 0; bj < 2; ++bj) { float r = scale;
                    if (mode != 0) { const LAS float* q = qb + (ai * 128 + m * 16) * 8 + bj * 4;
                        float sq; if (mode == 1) sq = (q[wc & 2] + q[(wc & 2) + 1]) * (1.f / 64.f); else sq = ((q[0] + q[1]) + (q[2] + q[3])) * (1.f / 128.f);
                        r = scale * frsq(sq + EPS); }
                    const f32x4 v0 = acc[ai][bj][m][0] * r * gv[0], v1 = acc[ai][bj][m][1] * r * gv[1];
                    u32x4 w; w.x = cvtpk(v0[0], v0[1]); w.y = cvtpk(v0[2], v0[3]); w.z = cvtpk(v1[0], v1[1]); w.w = cvtpk(v1[2], v1[3]);
                    if (skip == 2) asm volatile("" :: "v"(w)); else *(u32x4*)(rowp + bj * 256) = w; } }
        if (mode != 0) EPI_BAR();
    }
};
struct SchedTiles {
    const char* A; const char* B; int nM, nN, lda, ldb, nt, G, c;
    __device__ __forceinline__ bool next(int i, Unit& u) const {
        const int L = i * G + c; if (L >= nM * nN) return false;
        int pm, pn; pg8::tile_of(L, nM, nN, pm, pn); u.A = A + (size_t)pm * 256 * lda * 2; u.B = B + (size_t)pn * 256 * ldb * 2; u.nt = nt; u.pm = pm; u.pn = pn; u.kind = 0; return true;
    }
};
struct EpiGate {
    typedef EpiNoState State;
    bf16_t *OF, *OB, *NMQ; const float* gla_out_g; int skip;
    __device__ __forceinline__ void operator()(f32x4 (&acc)[2][2][4][2], const Unit& u, int wr, int wc, int fr_, int fq_, LAS unsigned char* le, State& est) const {
        if (skip == 1) { _Pragma("unroll") for (int a_ = 0; a_ < 2; ++a_) _Pragma("unroll") for (int m_ = 0; m_ < 4; ++m_) asm volatile("" :: "v"(acc[a_][0][m_][0]), "v"(acc[a_][0][m_][1]), "v"(acc[a_][1][m_][0]), "v"(acc[a_][1][m_][1])); return; }
        const int fr = (int)opaque((unsigned)fr_), fq = (int)opaque((unsigned)fq_);
        const int pn = u.pn; const int cw = wc * 32 + 8 * fq;
        const unsigned vo = opaque((unsigned)((wr * 64 + fr) * 1024 + cw) * 2u);
        if (pn < 4) {
            char* of = (char*)OF + ((size_t)u.pm * 256 * 1024 + pn * 256) * 2; const char* ob = (const char*)OB + ((size_t)u.pm * 256 * 1024 + pn * 256) * 2;
            LAS float* Pl = (LAS float*)le;
            u32x4 tp[8][2];
            u32x4 la[8][2], lb[8][2];
            constexpr int PD = 3;
#pragma unroll
            for (int g = 0; g < PD; ++g)
#pragma unroll
                for (int bj = 0; bj < 2; ++bj) { la[g][bj] = *(const u32x4*)(of + GOFF(g) + bj * 256 + vo); lb[g][bj] = *(const u32x4*)(ob + GOFF(g) + bj * 256 + vo); }
#pragma unroll
            for (int g = 0; g < 8; ++g) { const int ai = g >> 2, m = g & 3;
                asm volatile("" : "+v"(acc[ai][0][m][0]), "+v"(acc[ai][0][m][1]), "+v"(acc[ai][1][m][0]), "+v"(acc[ai][1][m][1]) :: "memory");
                if (g + PD < 8) {
#pragma unroll
                    for (int bj = 0; bj < 2; ++bj) { la[g + PD][bj] = *(const u32x4*)(of + GOFF(g + PD) + bj * 256 + vo); lb[g + PD][bj] = *(const u32x4*)(ob + GOFF(g + PD) + bj * 256 + vo); } }
#pragma unroll
                for (int bj = 0; bj < 2; ++bj) { const u32x4 a = la[g][bj], b = lb[g][bj]; float sq = 0.f; u32x4 tw;
#pragma unroll
                    for (int e = 0; e < 4; ++e) { const float a0 = e < 2 ? acc[ai][bj][m][0][2 * e] : acc[ai][bj][m][1][2 * e - 4], a1 = e < 2 ? acc[ai][bj][m][0][2 * e + 1] : acc[ai][bj][m][1][2 * e - 3];
                        const float lo = bf_lo(a[e]) + bf_lo(b[e]), hi = bf_hi(a[e]) + bf_hi(b[e]); sq += lo * lo + hi * hi; tw[e] = cvtpk(lo * silu_f(a0), hi * silu_f(a1)); }
                    asm volatile("" : "+v"(tw), "+v"(sq));
                    tp[g][bj] = tw;
                    pg8::ssq_put(sq, ai * 128 + wr * 64 + m * 16 + fr, bj, wc, fq, Pl); }
                asm volatile("" ::: "memory"); }
            EPI_BAR();
            const LAS float* qb = Pl + (wr * 64 + fr) * 8; const unsigned vo2 = opaque(vo);
            f32x4 g0v[2], g1v[2];
#pragma unroll
            for (int bj = 0; bj < 2; ++bj) { g0v[bj] = *(const f32x4*)(gla_out_g + bj * 128 + cw); g1v[bj] = *(const f32x4*)(gla_out_g + bj * 128 + cw + 4); }
#pragma unroll
            for (int g = 0; g < 8; ++g) { const int ai = g >> 2, m = g & 3;
                asm volatile("" : "+v"(tp[g][0]), "+v"(tp[g][1]) :: "memory");
                const LAS float* q = qb + (ai * 128 + m * 16) * 8;
                const float rstd = frsq((((q[0] + q[1]) + (q[2] + q[3])) + ((q[4] + q[5]) + (q[6] + q[7]))) * (1.f / 256.f) + EPS);
#pragma unroll
                for (int bj = 0; bj < 2; ++bj) { const u32x4 x = tp[g][bj]; u32x4 w;
#pragma unroll
                    for (int e = 0; e < 4; ++e) { const float g0 = e < 2 ? g0v[bj][2 * e] : g1v[bj][2 * e - 4], g1 = e < 2 ? g0v[bj][2 * e + 1] : g1v[bj][2 * e - 3];
                        w[e] = cvtpk(bf_lo(x[e]) * rstd * g0, bf_hi(x[e]) * rstd * g1); }
                    if (skip == 2) asm volatile("" :: "v"(w)); else *(u32x4*)(of + GOFF(g) + bj * 256 + vo2) = w; }
                asm volatile("" ::: "memory"); }
            EPI_BAR();
        } else {
            char* o = (char*)NMQ + ((size_t)u.pm * 256 * 1024 + (pn - 4) * 256) * 2;
            u32x4 la[8][2]; constexpr int PD = 5;
#pragma unroll
            for (int g = 0; g < PD; ++g)
#pragma unroll
                for (int bj = 0; bj < 2; ++bj) la[g][bj] = *(const u32x4*)(o + GOFF(g) + bj * 256 + vo);
#pragma unroll
            for (int g = 0; g < 8; ++g) { const int ai = g >> 2, m = g & 3;
                asm volatile("" : "+v"(acc[ai][0][m][0]), "+v"(acc[ai][0][m][1]), "+v"(acc[ai][1][m][0]), "+v"(acc[ai][1][m][1]) :: "memory");
                if (g + PD < 8) {
#pragma unroll
                    for (int bj = 0; bj < 2; ++bj) la[g + PD][bj] = *(const u32x4*)(o + GOFF(g + PD) + bj * 256 + vo); }
#pragma unroll
                for (int bj = 0; bj < 2; ++bj) { const u32x4 a = la[g][bj]; u32x4 w;
#pragma unroll
                    for (int e = 0; e < 4; ++e) { const float a0 = e < 2 ? acc[ai][bj][m][0][2 * e] : acc[ai][bj][m][1][2 * e - 4], a1 = e < 2 ? acc[ai][bj][m][0][2 * e + 1] : acc[ai][bj][m][1][2 * e - 3];
                        w[e] = cvtpk(bf_lo(a[e]) * silu_f(a0), bf_hi(a[e]) * silu_f(a1)); }
                    if (skip == 2) asm volatile("" :: "v"(w)); else *(u32x4*)(o + GOFF(g) + bj * 256 + vo) = w; }
                asm volatile("" ::: "memory"); }
        }
    }
};
struct SchedP3 {
    const char *H, *OA, *NMQ, *W; int G, c;
    __device__ __forceinline__ bool next(int i, Unit& u) const {
        const int ti = i / 6, seg = i - ti * 6; const int L = ti * G + c; if (L >= 512) return false;
        int pm, pn; pg8::tile_of(L, 128, 4, pm, pn);
        const char* a; int koff, nt;
        switch (seg) { case 0: a = H; koff = 0; nt = 16; break; case 1: a = OA; koff = 1024; nt = 16; break; case 2: a = H; koff = 2048; nt = 16; break;
                       case 3: a = NMQ; koff = 3072; nt = 8; break; case 4: a = H; koff = 3584; nt = 16; break; default: a = NMQ + 512 * 2; koff = 4608; nt = 8; break; }
        u.A = a + (size_t)pm * 256 * 1024 * 2; u.B = W + ((size_t)pn * 256 * KP3 + koff) * 2; u.nt = nt; u.pm = pm; u.pn = pn; u.kind = seg; return true;
    }
};
struct EpiP3 {
    struct State { u32x2 gc[8][2]; };
    bf16_t* Y;
    __device__ __forceinline__ void operator()(f32x4 (&acc)[2][2][4][2], const Unit& u, int wr, int wc, int fr_, int fq_, LAS unsigned char* le, State& est) const {
        const int fr = (int)opaque((unsigned)fr_), fq = (int)opaque((unsigned)fq_);
        const int seg = u.kind;
        if ((seg & 1) == 0) {
#pragma unroll
            for (int ai = 0; ai < 2; ++ai)
#pragma unroll
                for (int m = 0; m < 4; ++m) { asm volatile("" : "+v"(acc[ai][0][m][0]), "+v"(acc[ai][0][m][1]), "+v"(acc[ai][1][m][0]), "+v"(acc[ai][1][m][1]) :: "memory");
#pragma unroll
                    for (int bj = 0; bj < 2; ++bj) { u32x2 w;
#pragma unroll
                        for (int n = 0; n < 2; ++n) { const f32x4 v = acc[ai][bj][m][n]; unsigned p = 0u;
                            p = __builtin_amdgcn_cvt_pk_u8_f32(sigmoid_f(v[0]) * 255.f, 0, p); p = __builtin_amdgcn_cvt_pk_u8_f32(sigmoid_f(v[1]) * 255.f, 1, p);
                            p = __builtin_amdgcn_cvt_pk_u8_f32(sigmoid_f(v[2]) * 255.f, 2, p); p = __builtin_amdgcn_cvt_pk_u8_f32(sigmoid_f(v[3]) * 255.f, 3, p);
                            w[n] = p; }
                        asm volatile("" : "+v"(w));
                        est.gc[ai * 4 + m][bj] = w; } }
        } else {
            const unsigned vo = opaque((unsigned)((wr * 64 + fr) * 1024 + wc * 32 + 8 * fq) * 2u);
            char* yb = (char*)Y + ((size_t)u.pm * 256 * 1024 + u.pn * 256) * 2;
            u32x4 ly[8][2]; constexpr int PD = 3; constexpr float K = 1.0f / 255.0f;
            if (seg > 1) {
#pragma unroll
                for (int g = 0; g < PD; ++g)
#pragma unroll
                    for (int bj = 0; bj < 2; ++bj) ly[g][bj] = *(const u32x4*)(yb + GOFF(g) + bj * 256 + vo); }
#pragma unroll
            for (int g = 0; g < 8; ++g) { const int ai = g >> 2, m = g & 3;
                asm volatile("" : "+v"(acc[ai][0][m][0]), "+v"(acc[ai][0][m][1]), "+v"(acc[ai][1][m][0]), "+v"(acc[ai][1][m][1]), "+v"(est.gc[g][0]), "+v"(est.gc[g][1]) :: "memory");
#pragma unroll
                for (int bj = 0; bj < 2; ++bj) { const unsigned a0 = est.gc[g][bj][0], a1 = est.gc[g][bj][1]; const f32x4 v0 = acc[ai][bj][m][0], v1 = acc[ai][bj][m][1];
                    float o[8] = {v0[0] * ((float)(a0 & 0xffu) * K), v0[1] * ((float)((a0 >> 8) & 0xffu) * K), v0[2] * ((float)((a0 >> 16) & 0xffu) * K), v0[3] * ((float)(a0 >> 24) * K),
                                  v1[0] * ((float)(a1 & 0xffu) * K), v1[1] * ((float)((a1 >> 8) & 0xffu) * K), v1[2] * ((float)((a1 >> 16) & 0xffu) * K), v1[3] * ((float)(a1 >> 24) * K)};
                    if (seg > 1) { const u32x4 p = ly[g][bj];
                        o[0] += bf_lo(p.x); o[1] += bf_hi(p.x); o[2] += bf_lo(p.y); o[3] += bf_hi(p.y); o[4] += bf_lo(p.z); o[5] += bf_hi(p.z); o[6] += bf_lo(p.w); o[7] += bf_hi(p.w); }
                    u32x4 w; w.x = cvtpk(o[0], o[1]); w.y = cvtpk(o[2], o[3]); w.z = cvtpk(o[4], o[5]); w.w = cvtpk(o[6], o[7]);
                    *(u32x4*)(yb + GOFF(g) + bj * 256 + vo) = w; }
                if (seg > 1 && g + PD < 8) {
#pragma unroll
                    for (int bj = 0; bj < 2; ++bj) ly[g + PD][bj] = *(const u32x4*)(yb + GOFF(g + PD) + bj * 256 + vo); }
                asm volatile("" ::: "memory"); }
        }
    }
};
struct EpiP4 {
    typedef EpiNoState State;
    const float* xin; float* out;
    __device__ __forceinline__ void operator()(f32x4 (&acc)[2][2][4][2], const Unit& u, int wr, int wc, int fr_, int fq_, LAS unsigned char* le, State& est) const {
        const int fr = (int)opaque((unsigned)fr_), fq = (int)opaque((unsigned)fq_);
        const unsigned vo = opaque((unsigned)((wr * 64 + fr) * 1024 + wc * 32 + 8 * fq) * 4u);
        const size_t ubo = ((size_t)u.pm * 256 * 1024 + u.pn * 256) * 4; const char* xb = (const char*)xin + ubo; char* ob = (char*)out + ubo;
        f32x4 lx[8][2][2]; constexpr int PD = 3;
#pragma unroll
        for (int g = 0; g < PD; ++g)
#pragma unroll
            for (int bj = 0; bj < 2; ++bj)
#pragma unroll
                for (int n = 0; n < 2; ++n) lx[g][bj][n] = *(const f32x4*)(xb + 2 * GOFF(g) + vo + bj * 512 + 16 * n);
#pragma unroll
        for (int g = 0; g < 8; ++g) { const int ai = g >> 2, m = g & 3;
            asm volatile("" : "+v"(acc[ai][0][m][0]), "+v"(acc[ai][0][m][1]), "+v"(acc[ai][1][m][0]), "+v"(acc[ai][1][m][1]) :: "memory");
#pragma unroll
            for (int bj = 0; bj < 2; ++bj)
#pragma unroll
                for (int n = 0; n < 2; ++n) *(f32x4*)(ob + 2 * GOFF(g) + vo + bj * 512 + 16 * n) = lx[g][bj][n] + acc[ai][bj][m][n];
            if (g + PD < 8) {
#pragma unroll
                for (int bj = 0; bj < 2; ++bj)
#pragma unroll
                    for (int n = 0; n < 2; ++n) lx[g + PD][bj][n] = *(const f32x4*)(xb + 2 * GOFF(g + PD) + vo + bj * 512 + 16 * n); }
            asm volatile("" ::: "memory"); }
    }
};

__device__ __forceinline__ void glaprep_phase(const Ptrs& P, int l, LAS unsigned char* lds, int bx, int G, const int wv, const int probe) {
    const int tid = tid_of(wv), lane = tid & 63, w = __builtin_amdgcn_readfirstlane(tid >> 6), li = lane & 15, q4 = lane >> 4;
    constexpr int PSTR = 132, PTAB = 64 * PSTR * 4;
    const int st_tok = 8 * w + (lane >> 3), st_c = lane & 7;
    const unsigned lo_row = (unsigned)(st_tok * 1024 + st_c * 16);
    const unsigned lo_g = (unsigned)(li * 64 + 8 * q4) * 2u;
    char* GQb = (char*)(P.ws + WS_GQ); char* GKb = (char*)(P.ws + WS_GK); char* QBb = (char*)(P.ws + WS_QEB); char* KBb = (char*)(P.ws + WS_KEB);
    char* QFb = probe ? QBb : GQb; char* KFb = probe ? KBb : GKb;
    const char* GLb = (const char*)(P.ws + WS_GLR);
    float* DEC = (float*)(P.ws + WS_DEC);
#define PRE_S1(ga_, w2B_, bk_, BCd_, decp_, REV) do { f32x4 z_[4]; \
        _Pragma("unroll") for (int tt = 0; tt < 4; ++tt) z_[tt] = mfma16(ga_[tt], w2B_, (f32x4){bk_, bk_, bk_, bk_}); \
        float pv_[4][4], tot_[4]; \
        _Pragma("unroll") for (int tt = 0; tt < 4; ++tt) { float v_[4]; float run_ = 0.f; \
            _Pragma("unroll") for (int r = 0; r < 4; ++r) { const float zz = z_[tt][r]; const float ls2 = fminf(zz, 0.f) * LOG2E - __builtin_amdgcn_logf(1.f + fexp2(-fabsf(zz) * LOG2E)); \
                if (REV) v_[r] = run_; run_ += ls2 * (1.f / 16.f); if (!(REV)) v_[r] = run_; } \
              \
            const unsigned xb_ = __builtin_bit_cast(unsigned, run_); auto a_ = __builtin_amdgcn_permlane16_swap(xb_, xb_, false, false); \
            const float nb_ = __builtin_bit_cast(float, (q4 & 1) ? a_[0] : a_[1]); const float p_ = run_ + nb_; \
            const unsigned pb_ = __builtin_bit_cast(unsigned, p_); auto b_ = __builtin_amdgcn_permlane32_swap(pb_, pb_, false, false); \
            const float op_ = __builtin_bit_cast(float, (q4 & 2) ? b_[0] : b_[1]); \
            const float excl_ = ((q4 & 2) ? op_ : 0.f) + ((q4 & 1) ? nb_ : 0.f); tot_[tt] = p_ + op_; \
            _Pragma("unroll") for (int r = 0; r < 4; ++r) pv_[tt][r] = excl_ + v_[r]; } \
        const float o1_ = tot_[0], o2_ = o1_ + tot_[1], o3_ = o2_ + tot_[2], off_ = o3_ + tot_[3]; \
        _Pragma("unroll") for (int tt = 0; tt < 4; ++tt) { const float ot_ = tt == 0 ? 0.f : tt == 1 ? o1_ : tt == 2 ? o2_ : o3_; \
            _Pragma("unroll") for (int r = 0; r < 4; ++r) BCd_[(16 * tt + 4 * q4 + r) * PSTR + 16 * w + li] = (REV) ? off_ - (ot_ + pv_[tt][r]) : ot_ + pv_[tt][r]; } \
        if (q4 == 0) (decp_)[16 * w + li] = fexp2(off_); } while (0)
#define PRE_S2(BCd_, QEd_, KEd_) do { \
        _Pragma("unroll") for (int p_ = 0; p_ < 2; ++p_) { const LAS f32x4* bp = (const LAS f32x4*)(BCd_ + st_tok * PSTR + (st_c + 8 * p_) * 8); \
            const f32x4 b0 = bp[0], b1 = bp[1]; u32x4 qe, ke; \
            _Pragma("unroll") for (int e = 0; e < 4; ++e) { const float bl = e < 2 ? b0[2 * e] : b1[2 * e - 4], bh_ = e < 2 ? b0[2 * e + 1] : b1[2 * e - 3]; \
                const float el = fexp2(bl), eh = fexp2(bh_), il = fexp2(-bl), ih = fexp2(-bh_); \
                qe[e] = cvtpk(bf_lo(qv[p_][e]) * el, bf_hi(qv[p_][e]) * eh); ke[e] = cvtpk(bf_lo(kv[p_][e]) * il, bf_hi(kv[p_][e]) * ih); } \
            *(u32x4*)((QEd_) + uo + (size_t)p_ * 128 + lo_row) = qe; *(u32x4*)((KEd_) + uo + (size_t)p_ * 128 + lo_row) = ke; } } while (0)
    int par = 0;
#pragma unroll 1
    for (int u = bx; u < NB * 4 * 64; u += G) {
        const int ca = u & 63, h = (u >> 6) & 3, b = u >> 8;
        LAS float* BC0 = (LAS float*)(lds + par * 2 * PTAB); LAS float* BC1 = (LAS float*)(lds + par * 2 * PTAB + PTAB); par ^= 1;
        const float* w2f = P.w2f + (size_t)l * 16 * 512 + h * 128; const float* w2b = P.w2b + (size_t)l * 16 * 512 + h * 128;
        bf16x8 w2Bf, w2Bb; { unsigned pf[4], pb[4];
#pragma unroll
            for (int e = 0; e < 4; ++e) { const int r0 = (8 * q4 + 2 * e) & 15; pf[e] = cvtpk(w2f[r0 * 512 + 16 * w + li], w2f[(r0 + 1) * 512 + 16 * w + li]); pb[e] = cvtpk(w2b[r0 * 512 + 16 * w + li], w2b[(r0 + 1) * 512 + 16 * w + li]); }
            const u32x4 tf = {pf[0], pf[1], pf[2], pf[3]}, tb = {pb[0], pb[1], pb[2], pb[3]}; w2Bf = __builtin_bit_cast(bf16x8, tf); w2Bb = __builtin_bit_cast(bf16x8, tb); }
        const float bkf = P.bf[(size_t)l * 512 + h * 128 + 16 * w + li], bkb = P.bb[(size_t)l * 512 + h * 128 + 16 * w + li];
        const size_t tok0 = (size_t)b * SEQ + ca * 64;
        const size_t uo = tok0 * 1024 + h * 256;
        bf16x8 gaf[4], gab[4]; u32x4 qv[2], kv[2];
#pragma unroll
        for (int tt = 0; tt < 4; ++tt) { gaf[tt] = *(const bf16x8*)(GLb + (tok0 + 16 * tt) * 128 + lo_g); gab[tt] = *(const bf16x8*)(GLb + (tok0 + 16 * tt) * 128 + 64 + lo_g); }
#pragma unroll
        for (int p_ = 0; p_ < 2; ++p_) { qv[p_] = *(const u32x4*)(GQb + uo + (size_t)p_ * 128 + lo_row); kv[p_] = *(const u32x4*)(GKb + uo + (size_t)p_ * 128 + lo_row); }
        float* decf = DEC + ((size_t)((0 * NB + b) * 4 + h) * 64 + ca) * 128; float* decb = DEC + ((size_t)((1 * NB + b) * 4 + h) * 64 + ca) * 128;
        PRE_S1(gaf, w2Bf, bkf, BC0, decf, 0);
        PRE_S1(gab, w2Bb, bkb, BC1, decb, 1);
        asm volatile("s_waitcnt lgkmcnt(0)" ::: "memory"); __builtin_amdgcn_s_barrier(); asm volatile("" ::: "memory");
        PRE_S2(BC0, QFb, KFb);
        PRE_S2(BC1, QBb, KBb);
    }
#undef PRE_S1
#undef PRE_S2
}

constexpr int GL_BUF = 41984, GL_KEO = 16384, GL_VO = 32768, GL_DECO = 40960, GL_SB = 2 * GL_BUF, GL_XCH = GL_SB + 2 * 16384;
static_assert(GL_XCH + 2 * 8192 <= LDS_CTLW, "gla lds");
__device__ __forceinline__ int sw256(int row, int c) { return row * 256 + ((c ^ (row & 15)) << 4); }
__device__ __forceinline__ int sw128v(int row, int c) { return row * 128 + ((c ^ (((row >> 1) & 3) << 1)) << 4); }
__device__ __forceinline__ int sw128s(int row, int c) { return row * 128 + ((c ^ ((((row >> 1) & 1) | (((row >> 3) & 1) << 1)) << 1)) << 4); }
#define BAR_LDS() do { asm volatile("s_waitcnt lgkmcnt(0)" ::: "memory"); __builtin_amdgcn_s_barrier(); asm volatile("" ::: "memory"); } while (0)
__device__ __forceinline__ void gla_item(const Ptrs& P, int l, int item, LAS unsigned char* lds, const int wv) {
    const int tid = tid_of(wv), lane = tid & 63, w = __builtin_amdgcn_readfirstlane(tid >> 6), li = lane & 15, q4 = lane >> 4;
    const int xcd = item & 7, idx = item >> 3, bh = xcd * 4 + (idx >> 3), sub = idx & 7, j = sub & 3, dir = sub >> 2;
    const int b = bh >> 2, h = bh & 3;
    const char* QEb = (const char*)(P.ws + (dir ? WS_QEB : WS_GQ)) + ((size_t)b * SEQ * 512 + h * 128) * 2;
    const char* KEb = (const char*)(P.ws + (dir ? WS_KEB : WS_GK)) + ((size_t)b * SEQ * 512 + h * 128) * 2;
    const char* GVb = (const char*)(P.ws + WS_GV) + ((size_t)b * SEQ * 1024 + h * 256 + j * 64) * 2;
    char* Ob = (char*)(P.ws + (dir ? WS_OBW : WS_OF)) + ((size_t)b * SEQ * 1024 + h * 256 + j * 64) * 2;
    const float* DECb = (const float*)(P.ws + WS_DEC) + ((size_t)((dir * NB + b) * 4 + h) * 64) * 128;
    f32x4 ST[4];
#pragma unroll
    for (int k = 0; k < 4; ++k) ST[k] = (f32x4){0.f, 0.f, 0.f, 0.f};
    { LAS u32x4* z = (LAS u32x4*)(lds + GL_SB + 16384); const unsigned zz = opaque(0u); z[tid] = (u32x4){zz, zz, zz, zz}; z[tid + 512] = (u32x4){zz, zz, zz, zz}; }
    const int it = w >> 1, dt0 = (w & 1) * 2;
    const int sdt = w & 3, kt0 = (w >> 2) * 4;
    unsigned lo_d[2], lo_dv;
#pragma unroll
    for (int e = 0; e < 2; ++e) { const int tk = 8 * w + 4 * e + (lane >> 4), c16 = (lane & 15) ^ (tk & 15); lo_d[e] = (unsigned)((dir ? 63 - tk : tk) * 1024 + c16 * 16); }
    { const int row = 8 * w + (lane >> 3), c = (lane & 7) ^ (((row >> 1) & 3) << 1); lo_dv = (unsigned)((dir ? 63 - row : row) * 2048 + c * 16); }
#define GLA_DMA1(gb, vo, la) asm volatile("s_mov_b32 m0, %0\n\ts_nop 0\n\tglobal_load_lds_dwordx4 %1, %2" :: "s"((unsigned)(__UINTPTR_TYPE__)(la)), "v"(vo), "s"(gb) : "m0", "memory")
    const int dq0 = w == 1 ? 0 : w == 3 ? 4 : w == 0 ? 8 : w == 5 ? 9 : w == 2 ? 11 : w == 4 ? 12 : w == 6 ? 13 : 15;
    const int dqn = (w == 1 || w == 3) ? 4 : (w == 5 || w == 6) ? 2 : 1;
    const int dv0 = w == 0 ? 0 : w == 5 ? 1 : w == 2 ? 2 : w == 4 ? 4 : 6;
    const int dvn = (w == 1 || w == 3 || w == 6) ? 0 : (w == 0 || w == 5) ? 1 : 2;
#define GLA_DMA(cc, bo) do { const size_t ca_ = (size_t)(dir ? 63 - (cc) : (cc)) * 64; \
        for (int k_ = 0; k_ < dqn; ++k_) { const int i_ = dq0 + k_; const int tk_ = 4 * i_ + (lane >> 4); const unsigned o_ = (unsigned)((dir ? 63 - tk_ : tk_) * 1024 + (((lane & 15) ^ (tk_ & 15)) << 4)); \
            GLA_DMA1(QEb + ca_ * 1024, o_, lds + (bo) + i_ * 1024); GLA_DMA1(KEb + ca_ * 1024, o_, lds + (bo) + GL_KEO + i_ * 1024); } \
        for (int k_ = 0; k_ < dvn; ++k_) { const int i_ = dv0 + k_; const int row_ = 8 * i_ + (lane >> 3); const unsigned o_ = (unsigned)((dir ? 63 - row_ : row_) * 2048 + (((lane & 7) ^ (((row_ >> 1) & 3) << 1)) << 4)); \
            GLA_DMA1(GVb + ca_ * 2048, o_, lds + (bo) + GL_VO + i_ * 1024); } \
        if (w == 0) { unsigned long long sv_; asm volatile("s_mov_b64 %0, exec\n\ts_mov_b64 exec, 0xffffffff\n\ts_mov_b32 m0, %1\n\ts_nop 0\n\tglobal_load_lds_dwordx4 %2, %3\n\ts_mov_b64 exec, %0" \
            : "=&s"(sv_) : "s"((unsigned)(__UINTPTR_TYPE__)(lds + (bo) + GL_DECO)), "v"((unsigned)lane * 16u), "s"((const char*)DECb + ca_ * 8) : "m0", "memory"); } } while (0)
    GLA_DMA(0, 0);
    asm volatile("s_waitcnt vmcnt(0)" ::: "memory");
    __builtin_amdgcn_s_waitcnt(0x0F70);
    BAR_LDS();
    const int trr = (li >> 2), trc = ((li & 3) >> 1), trs = (li & 1) * 8;
    const int hf = w & 1; const bool act1 = 2 * hf <= it, act2 = 2 * hf + 1 <= it;
    const unsigned lo_o = (unsigned)((dir ? 63 - (16 * it + li) : 16 * it + li) * 1024 + 16 * dt0) * 2u + 16u * (unsigned)q4;
    f32x4 OTk[2] = {(f32x4){0.f, 0.f, 0.f, 0.f}, (f32x4){0.f, 0.f, 0.f, 0.f}};
#define GLA_FINAL(cc, xo) do { const u32x4 xp = *(const LAS u32x4*)(lds + GL_XCH + (xo) + (w ^ 1) * 1024 + lane * 16); \
          const size_t cb = (size_t)(dir ? 63 - (cc) : (cc)) * 64; u32x2 ov0, ov1; \
          ov0.x = cvtpk(OTk[0][0] + bf_lo(xp.x), OTk[0][1] + bf_hi(xp.x)); ov0.y = cvtpk(OTk[0][2] + bf_lo(xp.y), OTk[0][3] + bf_hi(xp.y)); \
          ov1.x = cvtpk(OTk[1][0] + bf_lo(xp.z), OTk[1][1] + bf_hi(xp.z)); ov1.y = cvtpk(OTk[1][2] + bf_lo(xp.w), OTk[1][3] + bf_hi(xp.w)); \
            \
          { auto r0 = __builtin_amdgcn_permlane32_swap(ov0.x, ov1.x, false, false); auto r1 = __builtin_amdgcn_permlane32_swap(ov0.y, ov1.y, false, false); \
            auto s0 = __builtin_amdgcn_permlane16_swap(r0[0], r0[1], false, false); auto s1 = __builtin_amdgcn_permlane16_swap(r1[0], r1[1], false, false); \
            const u32x4 ow = {s0[0], s1[0], s0[1], s1[1]}; *(u32x4*)(Ob + cb * 2048 + lo_o) = ow; } } while (0)
#pragma unroll 1
    for (int c2 = 0; c2 < 32; ++c2) {
#pragma unroll
      for (int sb = 0; sb < 2; ++sb) { const int c = 2 * c2 + sb; const int BO = sb * GL_BUF, SBR = GL_SB + (sb ^ 1) * 16384, SBW = GL_SB + sb * 16384, XR = (sb ^ 1) * 8192, XW = sb * 8192;
        if (c + 1 < 64) GLA_DMA(c + 1, (sb ^ 1) * GL_BUF);
        bf16x8 qb[4]; s16x4 sa[2][4][2]; s16x4 vi[4][2]; s16x4 vm[2][2]; s16x4 kb[4][2][2]; float dec[4]; bf16x8 ka1[4], ka2[4];
#pragma unroll
        for (int s = 0; s < 4; ++s) qb[s] = *(const LAS bf16x8*)(lds + BO + sw256(16 * it + li, 4 * s + q4));
#pragma unroll
        for (int dd = 0; dd < 2; ++dd)
#pragma unroll
            for (int s = 0; s < 4; ++s) { const int r0 = 32 * s + 8 * q4 + trr; const int cc = 2 * (dt0 + dd) + trc;
                sa[dd][s][0] = tr_read(lds + SBR + sw128s(r0, cc) + trs); sa[dd][s][1] = tr_read(lds + SBR + sw128s(r0 + 4, cc) + trs); }
        if (act1) {
#pragma unroll
            for (int s = 0; s < 4; ++s) ka1[s] = *(const LAS bf16x8*)(lds + BO + GL_KEO + sw256(32 * hf + li, 4 * s + q4)); }
        if (act2) {
#pragma unroll
            for (int s = 0; s < 4; ++s) ka2[s] = *(const LAS bf16x8*)(lds + BO + GL_KEO + sw256(32 * hf + 16 + li, 4 * s + q4)); }
        if (c > 0) GLA_FINAL(c - 1, XR);
        __builtin_amdgcn_sched_barrier(0);
        f32x4 OT[2] = {(f32x4){0.f, 0.f, 0.f, 0.f}, (f32x4){0.f, 0.f, 0.f, 0.f}};
#pragma unroll
        for (int s = 0; s < 4; ++s)
#pragma unroll
            for (int dd = 0; dd < 2; ++dd) OT[dd] = mfma16(cat44(sa[dd][s][0], sa[dd][s][1]), qb[s], OT[dd]);
        unsigned pk1[2] = {0u, 0u}, pk2[2] = {0u, 0u};
        if (act1) { f32x4 at = (f32x4){0.f, 0.f, 0.f, 0.f};
#pragma unroll
            for (int s = 0; s < 4; ++s) at = mfma16(ka1[s], qb[s], at);
            if (2 * hf == it) {
#pragma unroll
                for (int r = 0; r < 4; ++r) if (4 * q4 + r > li) at[r] = 0.f; }
            pk1[0] = cvtpk(at[0], at[1]); pk1[1] = cvtpk(at[2], at[3]); }
        if (act2) { f32x4 at = (f32x4){0.f, 0.f, 0.f, 0.f};
#pragma unroll
            for (int s = 0; s < 4; ++s) at = mfma16(ka2[s], qb[s], at);
            if (2 * hf + 1 == it) {
#pragma unroll
                for (int r = 0; r < 4; ++r) if (4 * q4 + r > li) at[r] = 0.f; }
            pk2[0] = cvtpk(at[0], at[1]); pk2[1] = cvtpk(at[2], at[3]); }
#pragma unroll
        for (int s = 0; s < 2; ++s) { const int r0 = 32 * s + 4 * q4 + trr; const int cc = 2 * sdt + trc;
            vm[s][0] = tr_read(lds + BO + GL_VO + sw128v(r0, cc) + trs); vm[s][1] = tr_read(lds + BO + GL_VO + sw128v(r0 + 16, cc) + trs); }
#pragma unroll
        for (int kk = 0; kk < 4; ++kk) { const int kt = kt0 + kk; dec[kk] = *(const LAS float*)(lds + BO + GL_DECO + (16 * kt + li) * 4);
#pragma unroll
            for (int s = 0; s < 2; ++s) { const int r0 = 32 * s + 4 * q4 + trr; const int cc = 2 * kt + trc;
                kb[kk][s][0] = tr_read(lds + BO + GL_KEO + sw256(r0, cc) + trs); kb[kk][s][1] = tr_read(lds + BO + GL_KEO + sw256(r0 + 16, cc) + trs); } }
        if (act1) {
#pragma unroll
            for (int dt = 0; dt < 4; ++dt) { const int r0 = 32 * hf + 4 * q4 + trr; const int cc = 2 * dt + trc;
                vi[dt][0] = tr_read(lds + BO + GL_VO + sw128v(r0, cc) + trs); vi[dt][1] = tr_read(lds + BO + GL_VO + sw128v(r0 + 16, cc) + trs); } }
        __builtin_amdgcn_sched_barrier(0);
#pragma unroll
        for (int kk = 0; kk < 4; ++kk) {
#pragma unroll
            for (int s = 0; s < 2; ++s) ST[kk] = mfma16(cat44(vm[s][0], vm[s][1]), cat44(kb[kk][s][0], kb[kk][s][1]), ST[kk]);
            ST[kk] = ST[kk] * dec[kk]; }
        f32x4 IP[4] = {(f32x4){0.f, 0.f, 0.f, 0.f}, (f32x4){0.f, 0.f, 0.f, 0.f}, (f32x4){0.f, 0.f, 0.f, 0.f}, (f32x4){0.f, 0.f, 0.f, 0.f}};
        if (act1) { const u32x4 bw = {pk1[0], pk1[1], pk2[0], pk2[1]}; const bf16x8 bfr = __builtin_bit_cast(bf16x8, bw);
#pragma unroll
            for (int dt = 0; dt < 4; ++dt) IP[dt] = mfma16(cat44(vi[dt][0], vi[dt][1]), bfr, IP[dt]); }
        { const f32x4 s0 = hf ? IP[0] : IP[2], s1 = hf ? IP[1] : IP[3];
          const u32x4 xw = {cvtpk(s0[0], s0[1]), cvtpk(s0[2], s0[3]), cvtpk(s1[0], s1[1]), cvtpk(s1[2], s1[3])};
          *(LAS u32x4*)(lds + GL_XCH + XW + w * 1024 + lane * 16) = xw; }
        OTk[0] = OT[0] + (hf ? IP[2] : IP[0]); OTk[1] = OT[1] + (hf ? IP[3] : IP[1]);
#pragma unroll
        for (int kk = 0; kk < 4; ++kk) { const int kr = 16 * (kt0 + kk) + li; u32x2 sv; sv.x = cvtpk(ST[kk][0], ST[kk][1]); sv.y = cvtpk(ST[kk][2], ST[kk][3]);
            *(LAS u32x2*)(lds + SBW + sw128s(kr, 2 * sdt + (q4 >> 1)) + (q4 & 1) * 8) = sv; }
        if (c > 0) asm volatile("s_waitcnt vmcnt(1)" ::: "memory"); else asm volatile("s_waitcnt vmcnt(0)" ::: "memory");
        BAR_LDS();
      }
    }
    GLA_FINAL(63, 8192);
#undef GLA_FINAL
#undef GLA_DMA1
#undef GLA_DMA
}

constexpr int NA_K = 0, NA_V = 73728, NA_RPB = 147456, NA_XCH = 149504;
__device__ __forceinline__ int swk128(int row, int c) { return row * 128 + ((c ^ ((row >> 1) & 7)) << 4); }
__device__ __forceinline__ int swv128(int row, int c) { return row * 128 + ((c ^ (row & 6)) << 4); }
__device__ __forceinline__ void na_item(const Ptrs& P, int l, int item, LAS unsigned char* lds, const int wv, bool do_store = true) {
    const int tid = tid_of(wv), lane = tid & 63, w = __builtin_amdgcn_readfirstlane(tid >> 6), li = lane & 15, q4 = lane >> 4;
    const int rg = item & 3, h = (item >> 2) & 7, b = item >> 5;
    const int r0 = rg * 16;
    const int t = w & 3, dh = w >> 2;
    const int c0 = t == 0 ? 0 : (t == 1 ? 8 : (t == 2 ? 24 : 32));
    char* NMQb = (char*)(P.ws + WS_NMQ) + ((size_t)b * SEQ * 1024 + h * 64) * 2;
    const char* NKb = (const char*)(P.ws + WS_NK) + ((size_t)b * SEQ * 512 + h * 64) * 2; const char* NVb = (const char*)(P.ws + WS_NV) + ((size_t)b * SEQ * 512 + h * 64) * 2;
    const int qc = 16 * t + li;
    const unsigned lo_q = (unsigned)(qc * 1024 + 8 * q4) * 2u;
    const unsigned lo_o = (unsigned)(qc * 1024 + 32 * dh) * 2u + 16u * (unsigned)q4;
    const int fk = tid >> 3, fc = tid & 7;
    const unsigned lo_f = (unsigned)(fk * 512 + fc * 8) * 2u;
    int rs = min(max(r0 - 4, 0), 56);
    struct NaPre { bf16x8 q[2]; u32x4 kv, vv; };
    NaPre S0, S1, S2;
#define NA_ISSUE(S, rr) do { const int rq_ = min((rr), 63); const int rk_ = min(max(rq_ - 4, 0), 56) + 7; \
        _Pragma("unroll") for (int s = 0; s < 2; ++s) (S).q[s] = *(const bf16x8*)(NMQb + (size_t)rq_ * 64 * 2048 + lo_q + s * 64); \
        (S).kv = *(const u32x4*)(NKb + (size_t)rk_ * 64 * 1024 + lo_f); (S).vv = *(const u32x4*)(NVb + (size_t)rk_ * 64 * 1024 + lo_f); } while (0)
    NA_ISSUE(S0, r0);
#pragma unroll
    for (int i = 0; i < 8; ++i) { const int ar = rs + i; const int slot = ar % 9; const size_t ro = (size_t)ar * 64 * 1024;
        const u32x4 kv = *(const u32x4*)(NKb + ro + lo_f), vv = *(const u32x4*)(NVb + ro + lo_f);
        *(LAS u32x4*)(lds + NA_K + slot * 8192 + swk128(fk, fc)) = kv; *(LAS u32x4*)(lds + NA_V + slot * 8192 + swv128(fk, fc)) = vv; }
    LAS float* RP = (LAS float*)(lds + NA_RPB);
    if (tid < 465) RP[tid] = P.rpb[((size_t)l * 8 + h) * 465 + tid] * LOG2E;
    asm volatile("s_waitcnt vmcnt(0)" ::: "memory");
    BAR_LDS();
    NA_ISSUE(S1, r0 + 1);
    const int cs = min(max(qc - 8, 0), 48);
    const int trr = li >> 2, trc = (li & 3) >> 1, trs = (li & 1) * 8;
    const int bh = dh;
    float bc_[4][2][4]; int cur_off = 1000;
    LAS unsigned char* xo_mine = lds + NA_XCH + w * 1024 + lane * 16; LAS unsigned char* xr_mine = lds + NA_XCH + 8192 + w * 256 + lane * 4;
    const LAS unsigned char* xo_part = lds + NA_XCH + (w ^ 4) * 1024 + lane * 16; const LAS unsigned char* xr_part = lds + NA_XCH + 8192 + (w ^ 4) * 256 + lane * 4;
    auto step = [&](NaPre& C, NaPre& A, NaPre& B, const int i) __attribute__((always_inline)) {
        const int r = r0 + i;
        if (rs - r != cur_off) { cur_off = rs - r;
#pragma unroll
            for (int sp = 0; sp < 4; ++sp) { const int drow = (cur_off + 4 * bh + sp + 7) * 31;
#pragma unroll
                for (int e = 0; e < 2; ++e)
#pragma unroll
                    for (int rr = 0; rr < 4; ++rr) { const int kcol = c0 + 16 * e + 4 * q4 + rr; const bool ok = (kcol >= cs) && (kcol < cs + 16);
                        const int dc = min(max(kcol - qc + 15, 0), 30); const float b_ = RP[drow + dc]; bc_[sp][e][rr] = ok ? b_ : -1e30f; } } }
        const int rsn = min(max(r + 1 - 4, 0), 56); const bool newrow = (i < 15) && (rsn != rs);
        NA_ISSUE(B, r + 2);
        f32x4 OT[4] = {(f32x4){0.f, 0.f, 0.f, 0.f}, (f32x4){0.f, 0.f, 0.f, 0.f}, (f32x4){0.f, 0.f, 0.f, 0.f}, (f32x4){0.f, 0.f, 0.f, 0.f}}; float rsum = 0.f;
        bf16x8 ka[4][2][2]; s16x4 va[4][4][2];
        { int slot = (rs + 4 * bh) % 9; int slots[4];
#pragma unroll
          for (int sp = 0; sp < 4; ++sp) { slots[sp] = slot; slot = slot == 8 ? 0 : slot + 1; }
#pragma unroll
          for (int sp = 0; sp < 4; ++sp) { const LAS unsigned char* kb_ = lds + NA_K + slots[sp] * 8192;
#pragma unroll
            for (int e = 0; e < 2; ++e)
#pragma unroll
                for (int s = 0; s < 2; ++s) ka[sp][e][s] = *(const LAS bf16x8*)(kb_ + swk128(c0 + 16 * e + li, 4 * s + q4)); }
#pragma unroll
          for (int sp = 0; sp < 4; ++sp) { const LAS unsigned char* vb_ = lds + NA_V + slots[sp] * 8192;
#pragma unroll
            for (int dt = 0; dt < 4; ++dt) { const int k0r = c0 + 4 * q4 + trr; const int cc = 2 * dt + trc;
                va[sp][dt][0] = tr_read(vb_ + swv128(k0r, cc) + trs); va[sp][dt][1] = tr_read(vb_ + swv128(k0r + 16, cc) + trs); } } }
        __builtin_amdgcn_sched_barrier(0);
#pragma unroll
        for (int sp = 0; sp < 4; ++sp) {
            unsigned pk[2][2];
#pragma unroll
            for (int e = 0; e < 2; ++e) { f32x4 sc = (f32x4){0.f, 0.f, 0.f, 0.f};
#pragma unroll
                for (int s = 0; s < 2; ++s) sc = mfma16(ka[sp][e][s], C.q[s], sc);
                float p[4];
#pragma unroll
                for (int rr = 0; rr < 4; ++rr) { p[rr] = fexp2(sc[rr] + bc_[sp][e][rr]); rsum += p[rr]; }
                pk[e][0] = cvtpk(p[0], p[1]); pk[e][1] = cvtpk(p[2], p[3]); }
            const u32x4 bw = {pk[0][0], pk[0][1], pk[1][0], pk[1][1]}; const bf16x8 bfr = __builtin_bit_cast(bf16x8, bw);
#pragma unroll
            for (int dt = 0; dt < 4; ++dt) OT[dt] = mfma16(cat44(va[sp][dt][0], va[sp][dt][1]), bfr, OT[dt]);
        }
        rsum = sum_x32(sum_x16(rsum, lane), lane);
        { const f32x4 s0 = bh ? OT[0] : OT[2], s1 = bh ? OT[1] : OT[3];
          const u32x4 xw = {cvtpk(s0[0], s0[1]), cvtpk(s0[2], s0[3]), cvtpk(s1[0], s1[1]), cvtpk(s1[2], s1[3])};
          *(LAS u32x4*)xo_mine = xw; *(LAS float*)xr_mine = rsum; }
        BAR_LDS();
        const u32x4 xp = *(const LAS u32x4*)xo_part; const float rtot = rsum + *(const LAS float*)xr_part;
        const f32x4 m0 = bh ? OT[2] : OT[0], m1 = bh ? OT[3] : OT[1];
        const float inv = frcp(rtot);
        u32x2 ov0, ov1;
        ov0.x = cvtpk((m0[0] + bf_lo(xp.x)) * inv, (m0[1] + bf_hi(xp.x)) * inv); ov0.y = cvtpk((m0[2] + bf_lo(xp.y)) * inv, (m0[3] + bf_hi(xp.y)) * inv);
        ov1.x = cvtpk((m1[0] + bf_lo(xp.z)) * inv, (m1[1] + bf_hi(xp.z)) * inv); ov1.y = cvtpk((m1[2] + bf_lo(xp.w)) * inv, (m1[3] + bf_hi(xp.w)) * inv);
        if (newrow) { const int slot_n = (rs + 8) % 9; *(LAS u32x4*)(lds + NA_K + slot_n * 8192 + swk128(fk, fc)) = A.kv; *(LAS u32x4*)(lds + NA_V + slot_n * 8192 + swv128(fk, fc)) = A.vv; }
        { auto r0 = __builtin_amdgcn_permlane32_swap(ov0.x, ov1.x, false, false); auto r1 = __builtin_amdgcn_permlane32_swap(ov0.y, ov1.y, false, false);
          auto s0 = __builtin_amdgcn_permlane16_swap(r0[0], r0[1], false, false); auto s1 = __builtin_amdgcn_permlane16_swap(r1[0], r1[1], false, false);
          const u32x4 ow = {s0[0], s1[0], s0[1], s1[1]};
          if (do_store) *(u32x4*)(NMQb + (size_t)r * 64 * 2048 + lo_o) = ow; else asm volatile("" :: "v"(ow)); }
        BAR_LDS();
        rs = rsn;
    };
#pragma unroll 1
    for (int i3 = 0; i3 < 15; i3 += 3) { step(S0, S1, S2, i3); step(S1, S2, S0, i3 + 1); step(S2, S0, S1, i3 + 2); }
    step(S0, S1, S2, 15);
#undef NA_ISSUE
}

constexpr int MA_K = 0, MA_V = 65536;
__device__ __forceinline__ int swm(int row, int c) { return row * 256 + ((c ^ (row & 15)) << 4); }
__device__ __forceinline__ int swmv(int row, int c) { return row * 256 + ((c ^ ((row & 7) << 1)) << 4); }
__device__ __forceinline__ void ma_item(const Ptrs& P, int item, LAS unsigned char* lds, const int wv, bool do_store = true) {
    const int tid = tid_of(wv), lane = tid & 63, w = __builtin_amdgcn_readfirstlane(tid >> 6), r32 = lane & 31, hi = lane >> 5, li = lane & 15, g = lane >> 4;
    const int qcx = item & 7, h = (item >> 3) & 3, b = item >> 5;
    const bf16_t* MK = (const bf16_t*)(P.ws + WS_MK) + (size_t)b * MEML * 512 + h * 128;
    const bf16_t* MV = (const bf16_t*)(P.ws + WS_MV) + (size_t)b * MEML * 512 + h * 128;
    bf16_t* MQ = (bf16_t*)(P.ws + WS_NMQ) + 512 + h * 128;
#pragma unroll
    for (int i = 0; i < 8; ++i) { const int ch = tid + i * 512; const int key = ch >> 4, c = ch & 15;
        const u32x4 kv = *(const u32x4*)(MK + (size_t)key * 512 + c * 8), vv = *(const u32x4*)(MV + (size_t)key * 512 + c * 8);
        *(LAS u32x4*)(lds + MA_K + swm(key, c)) = kv; *(LAS u32x4*)(lds + MA_V + swmv(key, c)) = vv; }
    __syncthreads();
    const int kx = r32 & 15; const int kro = r32 * 256;
    const int vrow = 4 * hi + (li >> 2); const int vx = (vrow & 7) << 1; const int vc0 = 2 * (g & 1) + ((li & 3) >> 1); const int vro = vrow * 256 + (li & 1) * 8;
    int voff[4];
#pragma unroll
    for (int d = 0; d < 4; ++d) voff[d] = vro + (((4 * d + vc0) ^ vx) << 4);
    for (int si = 0; si < 2; ++si) {
        const size_t q0 = (size_t)b * SEQ + qcx * 512 + (w * 2 + si) * 32;
        bf16x8 qf[8];
#pragma unroll
        for (int s = 0; s < 8; ++s) qf[s] = *(const bf16x8*)(MQ + (q0 + r32) * 1024 + 16 * s + 8 * hi);
        f32x16 O[4];
#pragma unroll
        for (int d = 0; d < 4; ++d)
#pragma unroll
            for (int e = 0; e < 16; ++e) O[d][e] = 0.f;
        float rsum = 0.f;
#pragma unroll 1
        for (int kt = 0; kt < 8; ++kt) {
            const LAS unsigned char* kp = lds + MA_K + kt * 8192 + kro; const LAS unsigned char* vp = lds + MA_V + kt * 8192;
            bf16x8 ka[8]; s16x4 va[2][4][2];
#pragma unroll
            for (int s = 0; s < 8; ++s) ka[s] = *(const LAS bf16x8*)(kp + (((2 * s + hi) ^ kx) << 4));
#pragma unroll
            for (int s = 0; s < 2; ++s)
#pragma unroll
                for (int d = 0; d < 4; ++d) { va[s][d][0] = tr_read(vp + voff[d] + s * 4096); va[s][d][1] = tr_read(vp + voff[d] + s * 4096 + 2048); }
            f32x16 sc0, sc1;
#pragma unroll
            for (int e = 0; e < 16; ++e) { sc0[e] = 0.f; sc1[e] = 0.f; }
#pragma unroll
            for (int s = 0; s < 4; ++s) { sc0 = mfma32(ka[2 * s], qf[2 * s], sc0); sc1 = mfma32(ka[2 * s + 1], qf[2 * s + 1], sc1); }
            unsigned pw[8];
#pragma unroll
            for (int e = 0; e < 8; ++e) { const float p0 = fexp2(sc0[2 * e] + sc1[2 * e]), p1 = fexp2(sc0[2 * e + 1] + sc1[2 * e + 1]); rsum += p0 + p1; pw[e] = cvtpk(p0, p1); }
#pragma unroll
            for (int s = 0; s < 2; ++s) { const u32x4 bw = {pw[4 * s], pw[4 * s + 1], pw[4 * s + 2], pw[4 * s + 3]}; const bf16x8 bfr = __builtin_bit_cast(bf16x8, bw);
#pragma unroll
                for (int d = 0; d < 4; ++d) O[d] = mfma32(cat44(va[s][d][0], va[s][d][1]), bfr, O[d]); }
        }
        rsum = sum_x32(rsum, lane);
        const float inv = 1.0f / rsum;
#pragma unroll
        for (int d = 0; d < 4; ++d)
#pragma unroll
            for (int g4 = 0; g4 < 4; g4 += 2) {
                u32x2 a, b; a.x = cvtpk(O[d][4 * g4] * inv, O[d][4 * g4 + 1] * inv); a.y = cvtpk(O[d][4 * g4 + 2] * inv, O[d][4 * g4 + 3] * inv);
                b.x = cvtpk(O[d][4 * g4 + 4] * inv, O[d][4 * g4 + 5] * inv); b.y = cvtpk(O[d][4 * g4 + 6] * inv, O[d][4 * g4 + 7] * inv);
                auto rx = __builtin_amdgcn_permlane32_swap(a.x, b.x, false, false); auto ry = __builtin_amdgcn_permlane32_swap(a.y, b.y, false, false);
                const u32x4 ow = {rx[0], ry[0], rx[1], ry[1]};
                if (do_store) *(u32x4*)(MQ + (q0 + r32) * 1024 + 32 * d + 8 * g4 + 8 * hi) = ow; else asm volatile("" :: "v"(ow)); }
    }
    __syncthreads();
}

#define XB_TMO      128
#define XB_XCNT(j)  (256  + 64 * (j))
#define XB_XSUB(j)  (1280 + 64 * (j))
#define XB_XGEN(j)  (2304 + 64 * (j))
#define XB_TOP      3328
#define XB_TOPGEN   3392
#define XCD_BAR_WORDS 3456
#define XB_SPIN_CAP (1u << 18)

__device__ __forceinline__ unsigned xb_ld(unsigned* p)              { return __hip_atomic_load(p, __ATOMIC_RELAXED, __HIP_MEMORY_SCOPE_AGENT); }
__device__ __forceinline__ unsigned xb_add(unsigned* p, unsigned v) { return __hip_atomic_fetch_add(p, v, __ATOMIC_RELAXED, __HIP_MEMORY_SCOPE_AGENT); }
__device__ __forceinline__ unsigned xb_xcc_id() { return (unsigned)__builtin_amdgcn_s_getreg((3 << 11) | 20) & 0xFu; }
#define XB_SPIN(cond, bar) do { unsigned _sp = 0; while (cond) { __builtin_amdgcn_s_sleep(1); \
    if ((++_sp & 255u) == 0u) { if (xb_ld(&(bar)[XB_TMO])) break; if (_sp > XB_SPIN_CAP) { atomicAdd(&(bar)[XB_TMO], 1u); break; } } } } while (0)

struct XcdBarrier {
    unsigned* bar; unsigned x;
    volatile LAS unsigned* st;
};

__device__ __forceinline__ XcdBarrier xcd_barrier_post(unsigned* bar, volatile LAS unsigned* st, const int wv) {
    XcdBarrier b; b.bar = bar; b.x = xb_xcc_id(); b.st = st;
    if (tid_of(wv) == 0) (void)xb_add(&bar[XB_XCNT(b.x)], 1u);
    return b;
}
__device__ __forceinline__ void xcd_barrier_complete(unsigned* bar, unsigned x, unsigned& nloc, unsigned& nx) {
    const unsigned G = gridDim.x * gridDim.y * gridDim.z;
    unsigned sum, cnt, mine, sp = 0u;
    for (;;) {
        sum = 0u; cnt = 0u; mine = 0u;
#pragma unroll
        for (unsigned j = 0; j < 16; ++j) { const unsigned c = xb_ld(&bar[XB_XCNT(j)]); sum += c; cnt += (c > 0u) ? 1u : 0u; mine = (j == x) ? c : mine; }
        if (sum == G) break;
        __builtin_amdgcn_s_sleep(1);
        if ((++sp & 255u) == 0u) { if (xb_ld(&bar[XB_TMO])) break; if (sp > XB_SPIN_CAP) { atomicAdd(&bar[XB_TMO], 1u); break; } }
    }
    nloc = mine > 0u ? mine : 1u; nx = cnt > 0u ? cnt : 1u;
}

__device__ __forceinline__ void xcd_barrier(const XcdBarrier& b, const int wv) {
    asm volatile("s_waitcnt vmcnt(0)" ::: "memory");
    __syncthreads();
    if (tid_of(wv) == 0) {
        unsigned* bar = b.bar;
        __builtin_amdgcn_s_waitcnt(0);
        unsigned nloc = b.st[0], nx = b.st[1];
        if (nloc == 0u) { xcd_barrier_complete(bar, b.x, nloc, nx); b.st[0] = nloc; b.st[1] = nx; }
        const unsigned old = xb_add(&bar[XB_XSUB(b.x)], 1u);
        const unsigned gen = old / nloc;
        if (old + 1u == (gen + 1u) * nloc) {
            __builtin_amdgcn_fence(__ATOMIC_RELEASE, "agent");
            asm volatile("s_waitcnt vmcnt(0)" ::: "memory");
            const unsigned og = xb_add(&bar[XB_TOP], 1u);
            const unsigned tg = og / nx;
            if (og + 1u == (tg + 1u) * nx) xb_add(&bar[XB_TOPGEN], 1u);
            else XB_SPIN(xb_ld(&bar[XB_TOPGEN]) == tg, bar);
            __builtin_amdgcn_fence(__ATOMIC_ACQUIRE, "agent");
            xb_add(&bar[XB_XGEN(b.x)], 1u);
            asm volatile("s_waitcnt vmcnt(0)" ::: "memory");
        } else {
            XB_SPIN(xb_ld(&bar[XB_XGEN(b.x)]) == gen, bar);
            __builtin_amdgcn_fence(__ATOMIC_ACQUIRE, "agent");
            asm volatile("s_waitcnt vmcnt(0)" ::: "memory");
        }
    }
    __syncthreads();
}


constexpr int PH_PER_LAYER = 7, N_PHASES = DEPTH * PH_PER_LAYER;
__global__ void __launch_bounds__(NTHR, 2) fwd_kernel(Args args) {
    extern __shared__ __attribute__((aligned(16))) unsigned char lds_raw[];
    LAS unsigned char* lds = (LAS unsigned char*)lds_raw;
    Ptrs P;
    P.x = args.in[0]; P.mem = args.in[1]; P.norm_g = args.in[2]; P.w_in = args.in[3]; P.w2f = args.in[4]; P.bf = args.in[5]; P.w2b = args.in[6]; P.bb = args.in[7];
    P.gla_out_g = args.in[8]; P.p_a = args.in[9]; P.na_q_g = args.in[10]; P.na_k_g = args.in[11]; P.rpb = args.in[12]; P.p_b = args.in[13]; P.mem_norm_g = args.in[14];
    P.w_mem = args.in[15]; P.mem_q_g = args.in[16]; P.mem_k_g = args.in[17]; P.p_c = args.in[18]; P.w_out = args.in[19]; P.out = args.out; P.ws = args.ws;
    const int G = gridDim.x, bx0 = blockIdx.x;
    const int vcu = (G % 8 == 0) ? (bx0 % 8) * (G / 8) + bx0 / 8 : bx0;
    unsigned char* ws = args.ws;
    volatile LAS unsigned* ctlw = (volatile LAS unsigned*)(lds + LDS_CTLW);
    const int wv = __builtin_amdgcn_readfirstlane((int)(threadIdx.x >> 6));
    if (threadIdx.x < 16) ctlw[threadIdx.x] = 0u;
    __syncthreads();
    XcdBarrier bar; bar.bar = (unsigned*)(ws + WS_CTL); bar.x = 0; bar.st = nullptr;
    if (args.ph_hi - args.ph_lo > 1) bar = xcd_barrier_post((unsigned*)(ws + WS_CTL), ctlw, wv);
    for (int ph = args.ph_lo; ph < args.ph_hi; ++ph) {
        int l = ph / PH_PER_LAYER, p = ph % PH_PER_LAYER; asm volatile("" : "+s"(l), "+s"(p));
        const float* xin = l == 0 ? P.x : P.out;
        int bx = bx0; asm volatile("" : "+s"(bx));
        { GAS unsigned char* w_ = (GAS unsigned char*)args.ws; asm volatile("" : "+s"(w_)); ws = (unsigned char*)w_; P.ws = ws; }
        for (int rep = 0; rep < ((PROBE_REP >= 0 && PROBE_REP < 10 && PROBE_REP == p && l == 0) ? 2 : 1); ++rep) {
#ifndef ONLY_PHASE
#define ONLY_PHASE -1
#endif
#define PHSEL(k) (p == (k) && (ONLY_PHASE < 0 || ONLY_PHASE == (k)))
        if (PHSEL(0)) {
            p0_phase(P, l, lds, vcu, G, xin, wv);
        } else if (PHSEL(1)) {
            SchedP1 S{(const char*)(ws + WS_H), (const char*)(ws + WS_WIN), (const char*)(ws + WS_HMEM), (const char*)(ws + WS_WMEM), G, bx};
            if ((PROBE_REP == 11 || PROBE_REP == 12) && l == 0) { EpiP1 E0{ws, P.na_q_g + l * 64, P.na_k_g + l * 64, P.mem_q_g + l * 128, P.mem_k_g + l * 128, PROBE_REP - 10}; pg8::gemm_phase<EpiP1, SchedP1>(lds, 1024, 1024, S, E0, wv); }
            EpiP1 E{ws, P.na_q_g + l * 64, P.na_k_g + l * 64, P.mem_q_g + l * 128, P.mem_k_g + l * 128, 0};
            pg8::gemm_phase<EpiP1, SchedP1>(lds, 1024, 1024, S, E, wv);
        } else if (PHSEL(2)) {
            for (int st = 0; st < 2; ++st) {
                if ((st ^ ((0x22 >> (bx & 7)) & 1)) == 0) {
                    for (int it = bx; it < NB * 8 * 4; it += G) na_item(P, l, it, lds, wv);
                    for (int it = bx; it < NB * 4 * 8; it += G) ma_item(P, it, lds, wv);
                } else glaprep_phase(P, l, lds, bx, G, wv, 0);
                __syncthreads();
            }
        } else if (PHSEL(3)) {
            { int nrep = (PROBE_REP == 40 && l == 0) ? 2 : 1; asm volatile("" : "+s"(nrep));
              for (int rr = 0; rr < nrep; ++rr) for (int it = bx; it < 256; it += G) gla_item(P, l, it, lds, wv); }
        } else if (PHSEL(4)) {
            SchedTiles S{(const char*)(ws + WS_H), (const char*)(ws + WS_WGATE), 128, 8, 1024, 1024, 16, G, bx};
            if ((PROBE_REP == 13 || PROBE_REP == 17) && l == 0) { EpiGate E0{(bf16_t*)(ws + WS_OF), (bf16_t*)(ws + WS_OBW), (bf16_t*)(ws + WS_NMQ), P.gla_out_g + l * 256, PROBE_REP == 13 ? 1 : 2}; pg8::gemm_phase<EpiGate, SchedTiles>(lds, 1024, 1024, S, E0, wv); }
            EpiGate E{(bf16_t*)(ws + WS_OF), (bf16_t*)(ws + WS_OBW), (bf16_t*)(ws + WS_NMQ), P.gla_out_g + l * 256, 0};
            pg8::gemm_phase<EpiGate, SchedTiles>(lds, 1024, 1024, S, E, wv);
        } else if (PHSEL(5)) {
            SchedP3 S{(const char*)(ws + WS_H), (const char*)(ws + WS_OF), (const char*)(ws + WS_NMQ), (const char*)(ws + WS_WP3), G, bx};
            EpiP3 E{(bf16_t*)(ws + WS_Y)};
            pg8::gemm_phase<EpiP3, SchedP3>(lds, 1024, KP3, S, E, wv);
        } else if (PHSEL(6)) {
            SchedTiles S{(const char*)(ws + WS_Y), (const char*)(ws + WS_WOUT), 128, 4, 1024, 1024, 16, G, bx};
            EpiP4 E{xin, P.out};
            pg8::gemm_phase<EpiP4, SchedTiles>(lds, 1024, 1024, S, E, wv);
        }
        }
        if (ph + 1 < args.ph_hi) { xcd_barrier(bar, wv); }
    }
}

extern "C" void kernel_launch(void* const* d_in, const int* in_sizes, int n_in, void* d_out, int out_size, void* d_ws, size_t ws_size, hipStream_t stream) {
    static int grid = 0;
    if (grid == 0) {
        if (n_in != 20 || out_size != T * DM || ws_size < WS_END) { fprintf(stderr, "kernel_launch: unexpected problem (n_in %d out %d ws %zu)\n", n_in, out_size, ws_size); grid = -1; return; }
        int dev = 0, cus = 0, per_cu = 0;
        hipGetDevice(&dev); hipDeviceGetAttribute(&cus, hipDeviceAttributeMultiprocessorCount, dev);
        hipFuncSetAttribute((const void*)fwd_kernel, hipFuncAttributeMaxDynamicSharedMemorySize, LDS_BYTES);
        hipOccupancyMaxActiveBlocksPerMultiprocessor(&per_cu, (const void*)fwd_kernel, NTHR, LDS_BYTES);
        (void)hipGetLastError();
        if (per_cu < 1) { fprintf(stderr, "kernel_launch: occupancy query says %d blocks/CU\n", per_cu); per_cu = 1; }
        grid = cus;
    }
    if (grid < 0) return;
    Args a{};
    for (int i = 0; i < 20; ++i) a.in[i] = (const float*)d_in[i];
    a.out = (float*)d_out; a.ws = (unsigned char*)d_ws;
    if (MK_N_LAUNCHES == 1) {
        a.ph_lo = 0; a.ph_hi = N_PHASES;
        if (hipMemsetAsync((char*)d_ws + WS_CTL, 0, 65536, stream) != hipSuccess) { fprintf(stderr, "kernel_launch: memset of the barrier words failed\n"); return; }
        hipLaunchKernelGGL(fwd_kernel, dim3(grid), dim3(NTHR), LDS_BYTES, stream, a);
        const hipError_t e = hipPeekAtLastError();
        if (e != hipSuccess) fprintf(stderr, "launch failed: %s (grid %d)\n", hipGetErrorString(e), grid);
    } else {
        for (int ph = 0; ph < N_PHASES; ++ph) { a.ph_lo = ph; a.ph_hi = ph + 1; hipLaunchKernelGGL(fwd_kernel, dim3(grid), dim3(NTHR), LDS_BYTES, stream, a); }
    }
}
```
